# Optimizing an MI355X kernel written in HIP

```python
import math
import jax, jax.numpy as jnp
from jax import lax
import numpy as np

D_MODEL = 1024
BATCH = 32
SEQ = 2048
DEPTH = 2

D_MIX = D_MODEL
D_FF = 2816
EPS = 1e-6

CONV_W = D_MIX // 4
CONV_GROUPS = 4
CONV_K = 3

MLA_HEADS = 8
NOPE_DIM = 64
ROPE_DIM = 32
V_DIM = 64
Q_RANK = 256
KV_RANK = 128
QK_DIM = NOPE_DIM + ROPE_DIM
MLA_W = MLA_HEADS * V_DIM
ROPE_THETA = 10000.0
Q_BLOCK = 128

GMLP_W = D_MIX - CONV_W - MLA_W
GMLP_HEADS = 4
GMLP_HD = GMLP_W // GMLP_HEADS
CHUNK = 128

SPLITS = np.cumsum([CONV_W, CONV_W, CONV_W, Q_RANK, KV_RANK, ROPE_DIM, GMLP_W]).tolist()
N_IN = 3 * CONV_W + Q_RANK + KV_RANK + ROPE_DIM + 2 * GMLP_W

kernel_name = "hybrid_macaron_parallel_heads_encoder"


def rms_norm(x, g):
    xf = x.astype(jnp.float32)
    y = xf * lax.rsqrt(jnp.mean(xf * xf, axis=-1, keepdims=True) + EPS)
    return (y * g.astype(jnp.float32)).astype(x.dtype)


def swiglu_ffn(x, w_gu, w_down):
    gate, up = jnp.split(x @ w_gu, 2, axis=-1)
    return (jax.nn.silu(gate) * up) @ w_down


def rope_tables(seq, dim):
    pos = jnp.arange(seq, dtype=jnp.float32)
    inv = 1.0 / (ROPE_THETA ** (jnp.arange(0, dim, 2, dtype=jnp.float32) / dim))
    ang = pos[:, None] * inv[None, :]
    return jnp.cos(ang), jnp.sin(ang)


def apply_rope(x, cos, sin):
    cos = cos.astype(x.dtype)
    sin = sin.astype(x.dtype)
    x1, x2 = jnp.split(x, 2, axis=-1)
    return jnp.concatenate([x1 * cos - x2 * sin, x2 * cos + x1 * sin], axis=-1)


def short_conv_mixer(xc, gate_b, gate_c, conv_w, conv_b):
    z = gate_c * xc
    w = conv_w.astype(z.dtype)[:, None, :]
    conv = lax.conv_general_dilated(
        z, w, window_strides=(1,), padding=[(CONV_K // 2, CONV_K // 2)],
        dimension_numbers=("NWC", "WIO", "NWC"), feature_group_count=CONV_W)
    return gate_b * (conv + conv_b)


def mla_mixer(cq, ckv, k_rope, q_norm_g, w_uq, kv_norm_g, w_ukv, cos, sin):
    bsz, seq, _ = cq.shape
    q = (rms_norm(cq, q_norm_g) @ w_uq).reshape(bsz, seq, MLA_HEADS, QK_DIM)
    q_nope = q[..., :NOPE_DIM]
    q_rope = apply_rope(q[..., NOPE_DIM:], cos[None, :, None, :], sin[None, :, None, :])
    kv = (rms_norm(ckv, kv_norm_g) @ w_ukv).reshape(bsz, seq, MLA_HEADS, NOPE_DIM + V_DIM)
    k_nope, v = kv[..., :NOPE_DIM], kv[..., NOPE_DIM:]
    k_rope = apply_rope(k_rope, cos[None], sin[None])
    scale = 1.0 / math.sqrt(QK_DIM)
    nb = seq // Q_BLOCK
    qn_blocks = (q_nope * scale).reshape(bsz, nb, Q_BLOCK, MLA_HEADS, NOPE_DIM).transpose(1, 0, 2, 3, 4)
    qr_blocks = (q_rope * scale).reshape(bsz, nb, Q_BLOCK, MLA_HEADS, ROPE_DIM).transpose(1, 0, 2, 3, 4)

    def attend(blk):
        qn, qr = blk
        s = (jnp.einsum("bqhd,bkhd->bhqk", qn, k_nope)
             + jnp.einsum("bqhr,bkr->bhqk", qr, k_rope)).astype(jnp.float32)
        p = jax.nn.softmax(s, axis=-1).astype(v.dtype)
        return jnp.einsum("bhqk,bkhd->bqhd", p, v)

    o = lax.map(attend, (qn_blocks, qr_blocks))
    return o.transpose(1, 0, 2, 3, 4).reshape(bsz, seq, MLA_W)


def gmlp_mixer(zu, zv, norm_g, ws, bias):
    u = jax.nn.gelu(zu, approximate=False)
    v = rms_norm(jax.nn.gelu(zv, approximate=False), norm_g)
    bsz, seq, _ = v.shape
    v = v.reshape(bsz, seq // CHUNK, CHUNK, GMLP_HEADS, GMLP_HD)
    mixed = jnp.einsum("gpq,bcqgd->bcpgd", ws, v) + bias.T[None, None, :, :, None]
    return u * mixed.reshape(bsz, seq, GMLP_W)


def setup_inputs(seed: int = 0) -> dict:
    key = jax.random.key(seed)
    ks = jax.random.split(key, 24)
    L = DEPTH

    def nrm(k, shape, scale):
        return jax.random.normal(k, shape, jnp.float32) * scale

    def gain(k, shape):
        return 1.0 + 0.02 * jax.random.normal(k, shape, jnp.float32)

    return {
        "x": jax.random.normal(ks[0], (BATCH, SEQ, D_MODEL), jnp.float32),
        "ffn1_pre_g": gain(ks[1], (L, D_MODEL)),
        "ffn1_w_gu": nrm(ks[2], (L, D_MODEL, 2 * D_FF), D_MODEL ** -0.5),
        "ffn1_w_down": nrm(ks[3], (L, D_FF, D_MODEL), D_FF ** -0.5),
        "ffn1_post_g": gain(ks[4], (L, D_MODEL)),
        "mix_pre_g": gain(ks[5], (L, D_MODEL)),
        "w_in": nrm(ks[6], (L, D_MODEL, N_IN), D_MODEL ** -0.5),
        "conv_w": nrm(ks[7], (L, CONV_K, CONV_W), CONV_K ** -0.5),
        "conv_b": nrm(ks[8], (L, CONV_W), 0.02),
        "q_norm_g": gain(ks[9], (L, Q_RANK)),
        "w_uq": nrm(ks[10], (L, Q_RANK, MLA_HEADS * QK_DIM), Q_RANK ** -0.5),
        "kv_norm_g": gain(ks[11], (L, KV_RANK)),
        "w_ukv": nrm(ks[12], (L, KV_RANK, MLA_HEADS * (NOPE_DIM + V_DIM)), KV_RANK ** -0.5),
        "gmlp_norm_g": gain(ks[13], (L, GMLP_W)),
        "gmlp_ws": nrm(ks[14], (L, GMLP_HEADS, CHUNK, CHUNK), CHUNK ** -0.5),
        "gmlp_b": gain(ks[15], (L, GMLP_HEADS, CHUNK)),
        "w_out": nrm(ks[16], (L, D_MIX, D_MODEL), D_MIX ** -0.5),
        "mix_post_g": gain(ks[17], (L, D_MODEL)),
        "ffn2_pre_g": gain(ks[18], (L, D_MODEL)),
        "ffn2_w_gu": nrm(ks[19], (L, D_MODEL, 2 * D_FF), D_MODEL ** -0.5),
        "ffn2_w_down": nrm(ks[20], (L, D_FF, D_MODEL), D_FF ** -0.5),
        "ffn2_post_g": gain(ks[21], (L, D_MODEL)),
    }


def reference(x, ffn1_pre_g, ffn1_w_gu, ffn1_w_down, ffn1_post_g, mix_pre_g, w_in,
              conv_w, conv_b, q_norm_g, w_uq, kv_norm_g, w_ukv, gmlp_norm_g, gmlp_ws,
              gmlp_b, w_out, mix_post_g, ffn2_pre_g, ffn2_w_gu, ffn2_w_down, ffn2_post_g):
    cos, sin = rope_tables(x.shape[1], ROPE_DIM)
    for l in range(DEPTH):
        h = swiglu_ffn(rms_norm(x, ffn1_pre_g[l]), ffn1_w_gu[l], ffn1_w_down[l])
        x = x + 0.5 * rms_norm(h, ffn1_post_g[l])

        n = rms_norm(x, mix_pre_g[l])
        z = n @ w_in[l]
        xc, gb, gc, cq, ckv, kr, zu, zv = jnp.split(z, SPLITS, axis=-1)
        y_conv = short_conv_mixer(xc, gb, gc, conv_w[l], conv_b[l])
        y_mla = mla_mixer(cq, ckv, kr, q_norm_g[l], w_uq[l], kv_norm_g[l], w_ukv[l], cos, sin)
        y_gmlp = gmlp_mixer(zu, zv, gmlp_norm_g[l], gmlp_ws[l], gmlp_b[l])
        y = jnp.concatenate([y_conv, y_mla, y_gmlp], axis=-1) @ w_out[l]
        x = x + rms_norm(y, mix_post_g[l])

        h = swiglu_ffn(rms_norm(x, ffn2_pre_g[l]), ffn2_w_gu[l], ffn2_w_down[l])
        x = x + 0.5 * rms_norm(h, ffn2_post_g[l])
    return x
```

```cpp
#include <hip/hip_runtime.h>
#include <hip/hip_cooperative_groups.h>
#include <cstdio>
#include <cstdint>
namespace cg = cooperative_groups;
namespace pg8 {
#define PG8_LAS __attribute__((address_space(3)))
typedef unsigned short bf16_t;
typedef short bf16x8 __attribute__((ext_vector_type(8)));
typedef float f32x4 __attribute__((ext_vector_type(4)));
typedef unsigned u32x4 __attribute__((ext_vector_type(4)));
constexpr int BM = 256, BK = 64, HALF = 128, HTB = HALF * BK * 2  , STAGE_BYTES = 8 * HTB, NXCD = 8, WGM = 8;

__host__ __device__ __forceinline__ int lds_byte(int r, int c) { const int st = (r >> 4) * 2 + (c >> 5), rr = r & 15, cc = c & 31, ob = rr * 64 + cc * 2; return st * 1024 + (ob ^ (((ob >> 9) & 1) << 5)); }
__host__ __device__ __forceinline__ void stage_rc(int b, int& R, int& C) { const int st = b / 1024, sb = b % 1024, swz = sb ^ (((sb >> 9) & 1) << 5); R = (st >> 1) * 16 + swz / 64; C = (st & 1) * 32 + (swz % 64) / 2; }
__host__ __device__ __forceinline__ int perm32(int rho) { const int n = rho >> 4, i = rho & 15; return 8 * (i >> 2) + 4 * n + (i & 3); }

struct Unit { int pm, pn; };
struct Gemm { const bf16_t* A; const bf16_t* Bt; int M, N, K; };

struct StaticOrder {
    int nM, nN, nwg, G, c, i0, iend;
    __host__ __device__ void init(int M, int N, int G_, int c_) { nM = M / BM; nN = N / BM; nwg = nM * nN; G = G_; c = c_; i0 = 0; iend = 1 << 30; }
    __host__ __device__ bool next(int i, Unit& u) const {
        const long L = (long)(i + i0) * G + c; if (i + i0 >= iend || L >= nwg) return false;
        int wgid = (int)L; { const int q = nwg / NXCD, r = nwg % NXCD, xcd = wgid % NXCD, off = wgid / NXCD; wgid = (xcd < r ? xcd * (q + 1) : r * (q + 1) + (xcd - r) * q) + off; }
        const int nig = WGM * nN, gid = wgid / nig, fm = gid * WGM, gsz = (nM - fm) < WGM ? (nM - fm) : WGM;
        u.pm = fm + ((wgid % nig) % gsz); u.pn = (wgid % nig) / gsz; return true;
    }
    __device__ __forceinline__ void a_ready(const Unit&) const {}
    __device__ __forceinline__ void done(const Unit&) const {}
};

__device__ __forceinline__ unsigned cvt_pk_bf16(float lo, float hi) { unsigned r; asm volatile("v_cvt_pk_bf16_f32 %0, %1, %2" : "=v"(r) : "v"(lo), "v"(hi)); return r; }
typedef float f32x2 __attribute__((ext_vector_type(2)));
__device__ __forceinline__ f32x2 gelu_pk(f32x2 v) {
    const f32x2 av = __builtin_elementwise_abs(v), d = av * 0.2316418882f + 1.0f;
    f32x2 t; t.x = __builtin_amdgcn_rcpf(d.x); t.y = __builtin_amdgcn_rcpf(d.y);
    f32x2 q = t * 0.5307027145f + (-0.7265760135f); q = q * t + 0.7107068705f; q = q * t + (-0.142248368f); q = q * t + 0.127414796f; q = q * t;
    const f32x2 s = (v * v) * (-0.72134752044f);
    f32x2 e; e.x = __builtin_amdgcn_exp2f(s.x); e.y = __builtin_amdgcn_exp2f(s.y);
    const f32x2 m = v * (q * e), r = v - m;
    f32x2 o; o.x = v.x < 0.f ? m.x : r.x; o.y = v.y < 0.f ? m.y : r.y; return o;
}
template <class Epi, class Sched, bool ALIGN_EPI = false, bool SP2 = false>
__device__ __forceinline__ void gemm_phase(PG8_LAS unsigned char* lds, const Gemm g, const Sched& S, const Epi& E, const int tid_in) {
    const int tid = tid_in, wid = __builtin_amdgcn_readfirstlane(tid >> 6), lane = tid & 63, wr = wid >> 2, wc = wid & 3, fr = lane & 15, fq = lane >> 4;
    const int K = g.K, nt = K / BK;
    unsigned voffA[2], voffB[2];
#pragma unroll
    for (int i = 0; i < 2; ++i) { int R, C; stage_rc(tid * 16 + i * 8192, R, C); const int Rb = Epi::PERM ? ((R & ~31) + perm32(R & 31)) : R;
        voffA[i] = (unsigned)(R * K + C) * 2u; voffB[i] = (unsigned)(Rb * K + C) * 2u; }
    const size_t kstep = (size_t)(BK * 2);
    const size_t hstep = (size_t)HALF * K * 2;
    const size_t tstep = 2 * hstep;
    const unsigned ldsw = (unsigned)wid * 1024u;
    const int aoff = lds_byte(wr * 64 + fr, fq * 8), boff = lds_byte(wc * 32 + fr, fq * 8);
#define PG8_SA(b, h) (((b) * 2 + (h)) * HTB)
#define PG8_SB(b, h) ((4 + (b) * 2 + (h)) * HTB)
#define PG8_STAGE(bufoff, gbase, voff) do { _Pragma("unroll") for (int _i = 0; _i < 2; ++_i) \
        __builtin_amdgcn_global_load_lds((const unsigned*)((const char*)(gbase) + (voff)[_i]), (PG8_LAS unsigned*)(lds + (bufoff) + ldsw + _i * 8192), 16, 0, 0); } while (0)
#define PG8_LDA(dst, b, h) do { _Pragma("unroll") for (int m = 0; m < 4; ++m) _Pragma("unroll") for (int k = 0; k < 2; ++k) dst[m][k] = *(const PG8_LAS bf16x8*)(lds + PG8_SA(b, h) + aoff + m * 2048 + k * 1024); } while (0)
#define PG8_LDB(dst, b, h) do { _Pragma("unroll") for (int n = 0; n < 2; ++n) _Pragma("unroll") for (int k = 0; k < 2; ++k) dst[n][k] = *(const PG8_LAS bf16x8*)(lds + PG8_SB(b, h) + boff + n * 2048 + k * 1024); } while (0)
#define PG8_MMA(ai, bj, At, Bt) do { __builtin_amdgcn_s_setprio(1); _Pragma("unroll") for (int m = 0; m < 4; ++m) _Pragma("unroll") for (int n = 0; n < 2; ++n) _Pragma("unroll") for (int k = 0; k < 2; ++k) \
        acc[ai][bj][m][n] = __builtin_amdgcn_mfma_f32_16x16x32_bf16(Bt[n][k], At[m][k], acc[ai][bj][m][n], 0, 0, 0); __builtin_amdgcn_s_setprio(0); } while (0)
#define PG8_WAIT_V(n) asm volatile("s_waitcnt vmcnt(" #n ")" ::: "memory")
#define PG8_WAIT_L(n) asm volatile("s_waitcnt lgkmcnt(" #n ")" ::: "memory")
#define PG8_BAR __builtin_amdgcn_s_barrier()
#define PG8_SCHED __builtin_amdgcn_sched_barrier(0)
    Unit cur, nxt; int ui = 0;
    if (!S.next(0, cur)) return;
    f32x4 acc[2][2][4][2];
#pragma unroll
    for (int a = 0; a < 2; ++a)
#pragma unroll
        for (int b = 0; b < 2; ++b)
#pragma unroll
            for (int m = 0; m < 4; ++m)
#pragma unroll
                for (int n = 0; n < 2; ++n) acc[a][b][m][n] = (f32x4){0.f, 0.f, 0.f, 0.f};
    bf16x8 At[4][2], B0[2][2], B1[2][2];
    const char* cA = (const char*)g.A + (size_t)cur.pm * tstep; const char* cB = (const char*)g.Bt + (size_t)cur.pn * tstep;
    S.a_ready(cur);
    if constexpr (SP2) {
        PG8_STAGE(PG8_SB(0, 0), cB, voffB); PG8_STAGE(PG8_SB(0, 1), cB + hstep, voffB); PG8_STAGE(PG8_SA(0, 0), cA, voffA); PG8_STAGE(PG8_SA(0, 1), cA + hstep, voffA);
        if (wr == 1) PG8_BAR;
        PG8_WAIT_V(2); PG8_BAR;
        PG8_STAGE(PG8_SB(1, 0), cB + kstep, voffB); PG8_STAGE(PG8_SA(1, 0), cA + kstep, voffA); PG8_STAGE(PG8_SB(1, 1), cB + hstep + kstep, voffB);
        PG8_WAIT_V(6); PG8_BAR;
    } else {
        PG8_STAGE(PG8_SB(0, 0), cB, voffB); PG8_STAGE(PG8_SA(0, 0), cA, voffA); PG8_STAGE(PG8_SB(0, 1), cB + hstep, voffB); PG8_STAGE(PG8_SA(0, 1), cA + hstep, voffA);
        if (wr == 1) PG8_BAR;
        PG8_WAIT_V(4); PG8_BAR;
        PG8_STAGE(PG8_SB(1, 0), cB + kstep, voffB); PG8_STAGE(PG8_SA(1, 0), cA + kstep, voffA); PG8_STAGE(PG8_SB(1, 1), cB + hstep + kstep, voffB);
        PG8_WAIT_V(6); PG8_BAR;
    }
    for (;;) {
        const bool has_next = S.next(ui + 1, nxt);
        const char* nA = has_next ? (const char*)g.A + (size_t)nxt.pm * tstep : cA; const char* nB = has_next ? (const char*)g.Bt + (size_t)nxt.pn * tstep : cB;
        for (int t = 0; t < nt; t += 2) {
            const bool last = (t == nt - 2);
            const char* a1 = cA + (size_t)(t + 1) * kstep;
            const char* a2 = last ? nA : cA + (size_t)(t + 2) * kstep; const char* b2 = last ? nB : cB + (size_t)(t + 2) * kstep;
            const char* a3 = a2 + kstep; const char* b3 = b2 + kstep;
            if (last && has_next) S.a_ready(nxt);
            if constexpr (SP2) {
            PG8_LDB(B0, 0, 0); PG8_LDB(B1, 0, 1); PG8_SCHED; PG8_LDA(At, 0, 0); PG8_STAGE(PG8_SA(1, 1), a1 + hstep, voffA);
            PG8_WAIT_V(8); PG8_WAIT_L(0); PG8_BAR; PG8_MMA(0, 0, At, B0); PG8_MMA(0, 1, At, B1); PG8_BAR; PG8_SCHED;
            PG8_LDA(At, 0, 1); PG8_STAGE(PG8_SB(0, 0), b2, voffB); PG8_STAGE(PG8_SB(0, 1), b2 + hstep, voffB); PG8_STAGE(PG8_SA(0, 0), a2, voffA);
            PG8_WAIT_V(8); PG8_WAIT_L(0); PG8_BAR; PG8_MMA(1, 0, At, B0); PG8_MMA(1, 1, At, B1); PG8_BAR; PG8_SCHED;
            PG8_LDB(B0, 1, 0); PG8_LDB(B1, 1, 1); PG8_SCHED; PG8_LDA(At, 1, 0); PG8_STAGE(PG8_SA(0, 1), a2 + hstep, voffA);
            PG8_WAIT_V(8); PG8_WAIT_L(0); PG8_BAR; PG8_MMA(0, 0, At, B0); PG8_MMA(0, 1, At, B1); PG8_BAR; PG8_SCHED;
            PG8_LDA(At, 1, 1); PG8_STAGE(PG8_SB(1, 0), b3, voffB); PG8_STAGE(PG8_SB(1, 1), b3 + hstep, voffB); PG8_STAGE(PG8_SA(1, 0), a3, voffA);
            PG8_WAIT_V(8); PG8_WAIT_L(0); PG8_BAR; PG8_MMA(1, 0, At, B0); PG8_MMA(1, 1, At, B1); PG8_BAR; PG8_SCHED;
            } else {
            PG8_LDB(B0, 0, 0); PG8_SCHED; PG8_LDA(At, 0, 0); PG8_STAGE(PG8_SA(1, 1), a1 + hstep, voffA);
            PG8_WAIT_L(8); PG8_BAR; PG8_WAIT_L(0); PG8_MMA(0, 0, At, B0); PG8_BAR; PG8_SCHED;
            PG8_LDB(B1, 0, 1); PG8_STAGE(PG8_SB(0, 0), b2, voffB);
            PG8_BAR; PG8_WAIT_L(0); PG8_MMA(0, 1, At, B1); PG8_BAR;
            PG8_LDA(At, 0, 1); PG8_STAGE(PG8_SA(0, 0), a2, voffA);
            PG8_BAR; PG8_WAIT_L(0); PG8_MMA(1, 0, At, B0); PG8_BAR; PG8_SCHED;
            PG8_STAGE(PG8_SB(0, 1), b2 + hstep, voffB);
            PG8_WAIT_V(6); PG8_BAR; PG8_MMA(1, 1, At, B1); PG8_BAR;
            PG8_LDB(B0, 1, 0); PG8_SCHED; PG8_LDA(At, 1, 0); PG8_STAGE(PG8_SA(0, 1), a2 + hstep, voffA);
            PG8_WAIT_L(8); PG8_BAR; PG8_WAIT_L(0); PG8_MMA(0, 0, At, B0); PG8_BAR; PG8_SCHED;
            PG8_LDB(B1, 1, 1); PG8_STAGE(PG8_SB(1, 0), b3, voffB);
            PG8_BAR; PG8_WAIT_L(0); PG8_MMA(0, 1, At, B1); PG8_BAR;
            PG8_LDA(At, 1, 1); PG8_STAGE(PG8_SA(1, 0), a3, voffA);
            PG8_BAR; PG8_WAIT_L(0); PG8_MMA(1, 0, At, B0); PG8_BAR; PG8_SCHED;
            PG8_STAGE(PG8_SB(1, 1), b3 + hstep, voffB);
            PG8_WAIT_V(6); PG8_BAR; PG8_MMA(1, 1, At, B1); PG8_BAR;
            }
        }
        if constexpr (ALIGN_EPI) { if (wr == 0) PG8_BAR; }
        if constexpr (!Epi::AFTER_DRAIN) { E(acc, cur, wr, wc, fr, fq); S.done(cur); }
        if (!has_next) break;
#pragma unroll
        for (int a = 0; a < 2; ++a)
#pragma unroll
            for (int b = 0; b < 2; ++b)
#pragma unroll
                for (int m = 0; m < 4; ++m)
#pragma unroll
                    for (int n = 0; n < 2; ++n) acc[a][b][m][n] = (f32x4){0.f, 0.f, 0.f, 0.f};
        cur = nxt; cA = nA; cB = nB; ++ui;
        if constexpr (ALIGN_EPI) { if (wr == 1) PG8_BAR; }
    }
    PG8_WAIT_V(0);
    if constexpr (!ALIGN_EPI) { if (wr == 0) PG8_BAR; }
    PG8_BAR;
    if constexpr (Epi::AFTER_DRAIN) { E.fused(acc, cur, wr, wc, fr, fq, lds, wid, lane); S.done(cur); }
#undef PG8_SA
#undef PG8_SB
#undef PG8_STAGE
#undef PG8_LDA
#undef PG8_LDB
#undef PG8_MMA
#undef PG8_WAIT_V
#undef PG8_WAIT_L
#undef PG8_BAR
#undef PG8_SCHED
}
}

#define LAS __attribute__((address_space(3)))
using pg8::f32x4; using pg8::bf16_t; using pg8::Unit; using pg8::u32x4; using pg8::f32x2; using pg8::bf16x8;
typedef float f32x16 __attribute__((ext_vector_type(16)));
typedef short s16x4 __attribute__((ext_vector_type(4)));
typedef unsigned u32x2 __attribute__((ext_vector_type(2)));
typedef __bf16 bf16x2_t __attribute__((ext_vector_type(2)));

constexpr int T_TOK = 65536, SEQ = 2048, DM = 1024, DFF = 2816, NGU = 5632, NIN_P = 1792, NQ = 768, NKV = 1024;
constexpr float EPS = 1e-6f;
constexpr int NWAVES = 8, NTHR = 512;
constexpr int LDS_BYTES = 147456;
constexpr float QSCALE = 0.10206207261596575f * 1.4426950408889634f;

constexpr size_t MiB = 1u << 20;
constexpr size_t WS_ROPE = 1 * MiB;
constexpr size_t WS_PQ = 2 * MiB, WS_PKV = 3 * MiB, WS_PV = 4 * MiB, WS_RS = 5 * MiB;
constexpr size_t WS_W = 8 * MiB, WS_WL = 42 * MiB;
constexpr size_t WS_XN = 96 * MiB;
constexpr size_t WS_ACT = 224 * MiB;
constexpr size_t WS_ZC = 224 * MiB, WS_CQ = 320 * MiB, WS_U = 352 * MiB, WS_V = 384 * MiB, WS_CKV = 416 * MiB, WS_KR = 432 * MiB, WS_Q = 448 * MiB;
constexpr size_t WS_KV = 576 * MiB, WS_Y = 704 * MiB, WS_H = 832 * MiB, WS_END = 960 * MiB;

__device__ __forceinline__ unsigned cvtpk(float lo, float hi) { f32x2 v = {lo, hi}; bf16x2_t b = __builtin_convertvector(v, bf16x2_t); return __builtin_bit_cast(unsigned, b); }
__device__ __forceinline__ u32x4 pack8(f32x4 v0, f32x4 v1) { u32x4 w; w.x = cvtpk(v0[0], v0[1]); w.y = cvtpk(v0[2], v0[3]); w.z = cvtpk(v1[0], v1[1]); w.w = cvtpk(v1[2], v1[3]); return w; }
__device__ __forceinline__ unsigned short f2bf(float f) { unsigned u = __builtin_bit_cast(unsigned, f); return (unsigned short)((u + 0x7fffu + ((u >> 16) & 1u)) >> 16); }
__device__ __forceinline__ float bf2f(unsigned short b) { return __builtin_bit_cast(float, (unsigned)b << 16); }
__device__ __forceinline__ float bflo(unsigned w) { return __builtin_bit_cast(float, w << 16); }
__device__ __forceinline__ float bfhi(unsigned w) { return __builtin_bit_cast(float, w & 0xffff0000u); }
__device__ __forceinline__ float silu_mul(float g, float u) { return g * __builtin_amdgcn_rcpf(1.0f + __builtin_amdgcn_exp2f(-1.4426950408889634f * g)) * u; }
__device__ __forceinline__ f32x4 gelu4(f32x4 v) { f32x2 a = pg8::gelu_pk((f32x2){v[0], v[1]}), b = pg8::gelu_pk((f32x2){v[2], v[3]}); return (f32x4){a.x, a.y, b.x, b.y}; }
__device__ __forceinline__ float sumsq4(f32x4 v) { return (v[0] * v[0] + v[1] * v[1]) + (v[2] * v[2] + v[3] * v[3]); }
__device__ __forceinline__ float shflx(float v, int o, int lane) { return __builtin_bit_cast(float, __builtin_amdgcn_ds_bpermute((lane ^ o) << 2, __builtin_bit_cast(int, v))); }
__device__ __forceinline__ float wave_sum(float v, int lane) {
#pragma unroll
    for (int o = 1; o < 64; o <<= 1) v += shflx(v, o, lane);
    return v;
}

struct EpiPlain {
    static constexpr bool PERM = true, AFTER_DRAIN = false;
    bf16_t* O; int ldc;
    __device__ __forceinline__ void operator()(const f32x4 (&acc)[2][2][4][2], const Unit& u, int wr, int wc, int fr, int fq) const {
        const int row0 = u.pm * 256 + wr * 64 + fr, col0 = u.pn * 256 + wc * 32 + 8 * fq;
#pragma unroll
        for (int ai = 0; ai < 2; ++ai)
#pragma unroll
            for (int m = 0; m < 4; ++m) { bf16_t* rowp = O + (size_t)(row0 + ai * 128 + m * 16) * ldc + col0;
#pragma unroll
                for (int bj = 0; bj < 2; ++bj) *(u32x4*)(rowp + bj * 128) = pack8(acc[ai][bj][m][0], acc[ai][bj][m][1]); }
    }
};
struct EpiSwiGLU {
    static constexpr bool PERM = true, AFTER_DRAIN = false;
    bf16_t* O; const float* RS;
    __device__ __forceinline__ void operator()(const f32x4 (&acc)[2][2][4][2], const Unit& u, int wr, int wc, int fr, int fq) const {
        const int row0 = u.pm * 256 + wr * 64 + fr, col0 = u.pn * 128 + wc * 32 + 8 * fq;
#pragma unroll
        for (int ai = 0; ai < 2; ++ai)
#pragma unroll
            for (int m = 0; m < 4; ++m) {
                const f32x4 g0 = acc[ai][0][m][0], g1 = acc[ai][0][m][1], u0 = acc[ai][1][m][0], u1 = acc[ai][1][m][1];
                f32x4 r0, r1;
#pragma unroll
                for (int e = 0; e < 4; ++e) { r0[e] = silu_mul(g0[e], u0[e]); r1[e] = silu_mul(g1[e], u1[e]); }
                *(u32x4*)(O + (size_t)(row0 + ai * 128 + m * 16) * DFF + col0) = pack8(r0, r1);
            }
    }
};
struct EpiWin {
    static constexpr bool PERM = true, AFTER_DRAIN = false;
    bf16_t *ZC, *CQ, *U, *V, *CKV, *KR; float *PQ, *PV, *PKV; const float* rope; const float* RS;
    __device__ __forceinline__ void operator()(const f32x4 (&acc)[2][2][4][2], const Unit& u, int wr, int wc, int fr, int fq) const {
        const int row0 = u.pm * 256 + wr * 64 + fr, cw = wc * 32 + 8 * fq, pn = u.pn;
        if (pn < 3) {
#pragma unroll
            for (int ai = 0; ai < 2; ++ai)
#pragma unroll
                for (int m = 0; m < 4; ++m) { bf16_t* rowp = ZC + (size_t)(row0 + ai * 128 + m * 16) * 768 + pn * 256 + cw;
#pragma unroll
                    for (int bj = 0; bj < 2; ++bj) *(u32x4*)(rowp + bj * 128) = pack8(acc[ai][bj][m][0], acc[ai][bj][m][1]); }
        } else if (pn == 3) {
#pragma unroll
            for (int ai = 0; ai < 2; ++ai)
#pragma unroll
                for (int m = 0; m < 4; ++m) { const int row = row0 + ai * 128 + m * 16; bf16_t* rowp = CQ + (size_t)row * 256 + cw; float ss = 0.f;
#pragma unroll
                    for (int bj = 0; bj < 2; ++bj) { const f32x4 v0 = acc[ai][bj][m][0], v1 = acc[ai][bj][m][1]; ss += sumsq4(v0) + sumsq4(v1); *(u32x4*)(rowp + bj * 128) = pack8(v0, v1); }
                    ss += shflx(ss, 16, fq * 16 + fr); ss += shflx(ss, 32, fq * 16 + fr);
                    if (fq == 0) PQ[(size_t)row * 4 + wc] = ss; }
        } else if (pn == 4) {
#pragma unroll
            for (int ai = 0; ai < 2; ++ai)
#pragma unroll
                for (int m = 0; m < 4; ++m) { bf16_t* rowp = U + (size_t)(row0 + ai * 128 + m * 16) * 256 + cw;
#pragma unroll
                    for (int bj = 0; bj < 2; ++bj) *(u32x4*)(rowp + bj * 128) = pack8(gelu4(acc[ai][bj][m][0]), gelu4(acc[ai][bj][m][1])); }
        } else if (pn == 5) {
#pragma unroll
            for (int ai = 0; ai < 2; ++ai)
#pragma unroll
                for (int m = 0; m < 4; ++m) { const int row = row0 + ai * 128 + m * 16; bf16_t* rowp = V + (size_t)row * 256 + cw; float ss = 0.f;
#pragma unroll
                    for (int bj = 0; bj < 2; ++bj) { const f32x4 v0 = gelu4(acc[ai][bj][m][0]), v1 = gelu4(acc[ai][bj][m][1]); ss += sumsq4(v0) + sumsq4(v1); *(u32x4*)(rowp + bj * 128) = pack8(v0, v1); }
                    ss += shflx(ss, 16, fq * 16 + fr); ss += shflx(ss, 32, fq * 16 + fr);
                    if (fq == 0) PV[(size_t)row * 4 + wc] = ss; }
        } else {
#pragma unroll
            for (int ai = 0; ai < 2; ++ai)
#pragma unroll
                for (int m = 0; m < 4; ++m) { const int row = row0 + ai * 128 + m * 16;
                    const f32x4 v0 = acc[ai][0][m][0], v1 = acc[ai][0][m][1]; float ss = sumsq4(v0) + sumsq4(v1);
                    *(u32x4*)(CKV + (size_t)row * 128 + cw) = pack8(v0, v1);
                    ss += shflx(ss, 16, fq * 16 + fr); ss += shflx(ss, 32, fq * 16 + fr);
                    if (fq == 0) PKV[(size_t)row * 4 + wc] = ss;
                    if (wc == 0) {
                        const f32x4 a = acc[ai][1][m][0], b = acc[ai][1][m][1];
                        const f32x4* rp = (const f32x4*)(rope + ((size_t)(row & (SEQ - 1)) * 16 + 4 * fq) * 2);
                        const f32x4 c0 = rp[0], c1 = rp[1];
                        f32x4 ra, rb;
                        ra[0] = a[0] * c0[0] - a[1] * c0[1]; ra[1] = a[1] * c0[0] + a[0] * c0[1];
                        ra[2] = a[2] * c0[2] - a[3] * c0[3]; ra[3] = a[3] * c0[2] + a[2] * c0[3];
                        rb[0] = b[0] * c1[0] - b[1] * c1[1]; rb[1] = b[1] * c1[0] + b[0] * c1[1];
                        rb[2] = b[2] * c1[2] - b[3] * c1[3]; rb[3] = b[3] * c1[2] + b[2] * c1[3];
                        *(u32x4*)(KR + (size_t)row * 32 + 8 * fq) = pack8(ra, rb);
                    } }
        }
    }
};
struct EpiUq {
    static constexpr bool PERM = true, AFTER_DRAIN = false;
    bf16_t* Q; const float* PQ; const float* rope;
    __device__ __forceinline__ void operator()(const f32x4 (&acc)[2][2][4][2], const Unit& u, int wr, int wc, int fr, int fq) const {
        const int row0 = u.pm * 256 + wr * 64 + fr, col0 = u.pn * 256 + wc * 32 + 8 * fq;
#pragma unroll
        for (int ai = 0; ai < 2; ++ai)
#pragma unroll
            for (int m = 0; m < 4; ++m) { const int row = row0 + ai * 128 + m * 16;
                const f32x4 p = *(const f32x4*)(PQ + (size_t)row * 4);
                const float sc = QSCALE / sqrtf(((p[0] + p[1]) + (p[2] + p[3])) * (1.0f / 256.0f) + EPS);
#pragma unroll
                for (int bj = 0; bj < 2; ++bj) { const int c = col0 + bj * 128, w = c % 96;
                    f32x4 a = acc[ai][bj][m][0] * sc, b = acc[ai][bj][m][1] * sc;
                    if (w >= 64) {
                        const f32x4* rp = (const f32x4*)(rope + ((size_t)(row & (SEQ - 1)) * 16 + ((w - 64) >> 1)) * 2);
                        const f32x4 c0 = rp[0], c1 = rp[1]; f32x4 ra, rb;
                        ra[0] = a[0] * c0[0] - a[1] * c0[1]; ra[1] = a[1] * c0[0] + a[0] * c0[1];
                        ra[2] = a[2] * c0[2] - a[3] * c0[3]; ra[3] = a[3] * c0[2] + a[2] * c0[3];
                        rb[0] = b[0] * c1[0] - b[1] * c1[1]; rb[1] = b[1] * c1[0] + b[0] * c1[1];
                        rb[2] = b[2] * c1[2] - b[3] * c1[3]; rb[3] = b[3] * c1[2] + b[2] * c1[3];
                        a = ra; b = rb;
                    }
                    *(u32x4*)(Q + (size_t)row * NQ + c) = pack8(a, b); } }
    }
};
struct EpiUkv {
    static constexpr bool PERM = true, AFTER_DRAIN = false;
    bf16_t* KV; const float* PKV;
    __device__ __forceinline__ void operator()(const f32x4 (&acc)[2][2][4][2], const Unit& u, int wr, int wc, int fr, int fq) const {
        const int row0 = u.pm * 256 + wr * 64 + fr, col0 = u.pn * 256 + wc * 32 + 8 * fq;
#pragma unroll
        for (int ai = 0; ai < 2; ++ai)
#pragma unroll
            for (int m = 0; m < 4; ++m) { const int row = row0 + ai * 128 + m * 16;
                const f32x4 p = *(const f32x4*)(PKV + (size_t)row * 4);
                const float sc = 1.0f / sqrtf(((p[0] + p[1]) + (p[2] + p[3])) * (1.0f / 128.0f) + EPS);
#pragma unroll
                for (int bj = 0; bj < 2; ++bj) *(u32x4*)(KV + (size_t)row * NKV + col0 + bj * 128) = pack8(acc[ai][bj][m][0] * sc, acc[ai][bj][m][1] * sc); }
    }
};

struct MapId   { __device__ __forceinline__ int operator()(int n) const { return n; } };
struct MapGU   { __device__ __forceinline__ int operator()(int n) const { const int pn = n >> 8, w = n & 255; return w < 128 ? 128 * pn + w : DFF + 128 * pn + (w - 128); } };
struct MapIn   { __device__ __forceinline__ int operator()(int n) const {
    if (n < 1024) return n;
    if (n < 1280) return 1184 + (n - 1024);
    if (n < 1536) return 1440 + (n - 1280);
    if (n < 1664) return 1024 + (n - 1536);
    if (n < 1696) { const int j = n - 1664; return 1152 + (j >> 1) + 16 * (j & 1); }
    return -1; } };
struct MapUq   { __device__ __forceinline__ int operator()(int n) const { const int h = n / 96, w = n % 96; if (w < 64) return n; const int j = w - 64; return h * 96 + 64 + (j >> 1) + 16 * (j & 1); } };

template <class Map>
__device__ __forceinline__ void transpose_item(const float* __restrict__ W, int K, int Nsrc, bf16_t* __restrict__ WT, int Ndst, const float* __restrict__ gk, LAS float* scr, int item, int lane, Map map) {
    const int nblk = Ndst / 32, kb = item / nblk, nb = item % nblk, k0 = 64 * kb, n0 = 32 * nb;
    const int n4 = 4 * (lane & 7), ko = lane >> 3;
    const int s0 = map(n0 + n4), s1 = map(n0 + n4 + 1), s2 = map(n0 + n4 + 2), s3 = map(n0 + n4 + 3);
    const bool contig = (s0 >= 0) && (s1 == s0 + 1) && (s2 == s0 + 2) && (s3 == s0 + 3) && ((s0 & 3) == 0);
#pragma unroll
    for (int i = 0; i < 8; ++i) { const int kk = 8 * i + ko; f32x4 v = {0.f, 0.f, 0.f, 0.f};
        const float* wr = W + (size_t)(k0 + kk) * Nsrc;
        if (contig) v = *(const f32x4*)(wr + s0);
        else { if (s0 >= 0) v[0] = wr[s0]; if (s1 >= 0) v[1] = wr[s1]; if (s2 >= 0) v[2] = wr[s2]; if (s3 >= 0) v[3] = wr[s3]; }
        if (gk) v = v * gk[k0 + kk];
        LAS float* d = scr + kk * 33 + n4; d[0] = v[0]; d[1] = v[1]; d[2] = v[2]; d[3] = v[3]; }
    asm volatile("s_waitcnt lgkmcnt(0)" ::: "memory");
    const int c = lane & 7;
#pragma unroll
    for (int j = 0; j < 4; ++j) { const int n = (lane >> 3) + 8 * j; const LAS float* s = scr + (8 * c) * 33 + n;
        u32x4 o; o.x = cvtpk(s[0 * 33], s[1 * 33]); o.y = cvtpk(s[2 * 33], s[3 * 33]); o.z = cvtpk(s[4 * 33], s[5 * 33]); o.w = cvtpk(s[6 * 33], s[7 * 33]);
        *(u32x4*)(WT + (size_t)(n0 + n) * K + k0 + 8 * c) = o; }
    asm volatile("s_waitcnt lgkmcnt(0)" ::: "memory");
}

struct Args { const float* in[22]; float* out; unsigned char* ws; int ph_lo, ph_hi; };

__device__ __forceinline__ bf16_t* wptr(unsigned char* ws, int layer, size_t off) { return (bf16_t*)(ws + WS_W + (size_t)layer * WS_WL + off); }
constexpr size_t OFF_GU1 = 0, OFF_GU2 = 11 * MiB, OFF_DN1 = 22 * MiB, OFF_DN2 = 28 * MiB, OFF_IN = 34 * MiB, OFF_OUT = 38 * MiB,
                 OFF_UQ = 40 * MiB, OFF_UKV = 40 * MiB + 512 * 1024, OFF_GWS = 41 * MiB;

__device__ __forceinline__ void rope_table(float* rope, int gtid, int gthreads) {
    for (int idx = gtid; idx < SEQ * 16; idx += gthreads) {
        const int pos = idx >> 4, i = idx & 15;
        const float inv = 1.0f / exp2f((float)i * 0.8304820237218406f);
        const float ang = (float)pos * inv;
        const double rev = (double)ang * 0.15915494309189535;
        const float fr = (float)(rev - __builtin_rint(rev));
        rope[2 * idx] = __builtin_amdgcn_cosf(fr); rope[2 * idx + 1] = __builtin_amdgcn_sinf(fr);
    }
}
__device__ __forceinline__ void prologue_weights(const Args& a, unsigned char* ws_, LAS unsigned char* lds, int gw, int NGW, int wave, int lane) {
    LAS float* scr = (LAS float*)(lds + wave * 16384);
    constexpr int I_GU = 16 * (NGU / 32), I_DN = (DFF / 64) * 32, I_IN = 16 * (NIN_P / 32), I_UQ = 4 * (NQ / 32), I_UKV = 2 * 32, I_OUT = 16 * 32;
    constexpr int PER_LAYER = 2 * I_GU + 2 * I_DN + I_IN + I_UQ + I_UKV + I_OUT;
    for (int it = gw; it < 2 * PER_LAYER; it += NGW) {
        const int l = it / PER_LAYER; int r = it % PER_LAYER;
        if (r < I_GU) { transpose_item(a.in[2] + (size_t)l * DM * NGU, DM, NGU, wptr(ws_, l, OFF_GU1), NGU, a.in[1] + l * DM, scr, r, lane, MapGU()); continue; } r -= I_GU;
        if (r < I_GU) { transpose_item(a.in[19] + (size_t)l * DM * NGU, DM, NGU, wptr(ws_, l, OFF_GU2), NGU, a.in[18] + l * DM, scr, r, lane, MapGU()); continue; } r -= I_GU;
        if (r < I_DN) { transpose_item(a.in[3] + (size_t)l * DFF * DM, DFF, DM, wptr(ws_, l, OFF_DN1), DM, nullptr, scr, r, lane, MapId()); continue; } r -= I_DN;
        if (r < I_DN) { transpose_item(a.in[20] + (size_t)l * DFF * DM, DFF, DM, wptr(ws_, l, OFF_DN2), DM, nullptr, scr, r, lane, MapId()); continue; } r -= I_DN;
        if (r < I_IN) { transpose_item(a.in[6] + (size_t)l * DM * 1696, DM, 1696, wptr(ws_, l, OFF_IN), NIN_P, a.in[5] + l * DM, scr, r, lane, MapIn()); continue; } r -= I_IN;
        if (r < I_UQ) { transpose_item(a.in[10] + (size_t)l * 256 * NQ, 256, NQ, wptr(ws_, l, OFF_UQ), NQ, a.in[9] + l * 256, scr, r, lane, MapUq()); continue; } r -= I_UQ;
        if (r < I_UKV) { transpose_item(a.in[12] + (size_t)l * 128 * NKV, 128, NKV, wptr(ws_, l, OFF_UKV), NKV, a.in[11] + l * 128, scr, r, lane, MapId()); continue; } r -= I_UKV;
        transpose_item(a.in[16] + (size_t)l * DM * DM, DM, DM, wptr(ws_, l, OFF_OUT), DM, nullptr, scr, r, lane, MapId());
    }
    for (int idx = (gw * 64 + lane); idx < 2 * 4 * 128 * 128 / 4; idx += NGW * 64) {
        const int l = idx / (4 * 128 * 128 / 4), e = idx % (4 * 128 * 128 / 4);
        const f32x4 v = *(const f32x4*)(a.in[14] + (size_t)l * 65536 + 4 * e);
        u32x2 o; o.x = cvtpk(v[0], v[1]); o.y = cvtpk(v[2], v[3]);
        *(u32x2*)(wptr(ws_, l, OFF_GWS) + 4 * e) = o;
    }
}

constexpr int RP = 4;
__device__ __forceinline__ void wave_sum4(float (&s)[RP], int lane) {
#pragma unroll
    for (int o = 1; o < 64; o <<= 1) {
        float t[RP];
#pragma unroll
        for (int k = 0; k < RP; ++k) t[k] = shflx(s[k], o, lane);
#pragma unroll
        for (int k = 0; k < RP; ++k) s[k] += t[k];
    }
}
__device__ __forceinline__ void bf8_to_f32(const u32x4 w, f32x4& a, f32x4& b) { a = (f32x4){bflo(w.x), bfhi(w.x), bflo(w.y), bfhi(w.y)}; b = (f32x4){bflo(w.z), bfhi(w.z), bflo(w.w), bfhi(w.w)}; }
__device__ __forceinline__ void row_pass(const float* __restrict__ xf, const bf16_t* xb, const bf16_t* __restrict__ H, float coef, const float* __restrict__ gpost,
                                         float* __restrict__ xout, bf16_t* XB, float* SC, int gw, int NGW, int lane) {
    f32x4 gp[2][2];
#pragma unroll
    for (int j = 0; j < 2; ++j)
#pragma unroll
        for (int q = 0; q < 2; ++q) gp[j][q] = H ? *(const f32x4*)(gpost + 8 * lane + 512 * j + 4 * q) * coef : (f32x4){0.f, 0.f, 0.f, 0.f};
#pragma unroll 1
    for (int rit = gw * RP; rit < T_TOK; rit += NGW * RP) {
        int row0 = rit;
        if (NGW * RP == 8192) { const int j = rit >> 13, li = rit & 8191, pl = li >> 8; row0 = (32 * (4 * (j & 1) + (pl >> 3)) + 8 * (3 - (j >> 1)) + (pl & 7)) * 256 + (li & 255); }
        f32x4 v[RP][2][2]; u32x4 hw[RP][2];
        if (xf) {
#pragma unroll
            for (int k = 0; k < RP; ++k)
#pragma unroll
                for (int j = 0; j < 2; ++j)
#pragma unroll
                    for (int q = 0; q < 2; ++q) v[k][j][q] = *(const f32x4*)(xf + (size_t)(row0 + k) * DM + 8 * lane + 512 * j + 4 * q);
        } else {
#pragma unroll
            for (int k = 0; k < RP; ++k) { const float sc = SC[row0 + k];
#pragma unroll
                for (int j = 0; j < 2; ++j) { const u32x4 w = *(const u32x4*)(xb + (size_t)(row0 + k) * DM + 8 * lane + 512 * j); bf8_to_f32(w, v[k][j][0], v[k][j][1]); v[k][j][0] = v[k][j][0] * sc; v[k][j][1] = v[k][j][1] * sc; } }
        }
        if (H) {
#pragma unroll
            for (int k = 0; k < RP; ++k)
#pragma unroll
                for (int j = 0; j < 2; ++j) hw[k][j] = *(const u32x4*)(H + (size_t)(row0 + k) * DM + 8 * lane + 512 * j);
            float ss[RP];
#pragma unroll
            for (int k = 0; k < RP; ++k) { ss[k] = 0.f;
#pragma unroll
                for (int j = 0; j < 2; ++j) { f32x4 h0, h1; bf8_to_f32(hw[k][j], h0, h1); ss[k] += sumsq4(h0) + sumsq4(h1); } }
            wave_sum4(ss, lane);
#pragma unroll
            for (int k = 0; k < RP; ++k) { const float rstd = 1.0f / sqrtf(ss[k] * (1.0f / DM) + EPS);
#pragma unroll
                for (int j = 0; j < 2; ++j) { f32x4 h0, h1; bf8_to_f32(hw[k][j], h0, h1); v[k][j][0] = v[k][j][0] + h0 * rstd * gp[j][0]; v[k][j][1] = v[k][j][1] + h1 * rstd * gp[j][1]; } }
        }
        if (xout) {
#pragma unroll
            for (int k = 0; k < RP; ++k)
#pragma unroll
                for (int j = 0; j < 2; ++j)
#pragma unroll
                    for (int q = 0; q < 2; ++q) *(f32x4*)(xout + (size_t)(row0 + k) * DM + 8 * lane + 512 * j + 4 * q) = v[k][j][q];
        }
        if (XB) {
            float ss[RP];
#pragma unroll
            for (int k = 0; k < RP; ++k) { ss[k] = 0.f;
#pragma unroll
                for (int j = 0; j < 2; ++j) ss[k] += sumsq4(v[k][j][0]) + sumsq4(v[k][j][1]); }
            wave_sum4(ss, lane);
#pragma unroll
            for (int k = 0; k < RP; ++k) { const float ms = ss[k] * (1.0f / DM) + EPS; const float rstd = 1.0f / sqrtf(ms);
#pragma unroll
                for (int j = 0; j < 2; ++j) *(u32x4*)(XB + (size_t)(row0 + k) * DM + 8 * lane + 512 * j) = pack8(v[k][j][0] * rstd, v[k][j][1] * rstd);
                if (lane == 0) SC[row0 + k] = sqrtf(ms); }
        }
    }
}

__device__ __forceinline__ void unpack8(const u32x4 w, float (&o)[8]) { o[0] = bflo(w.x); o[1] = bfhi(w.x); o[2] = bflo(w.y); o[3] = bfhi(w.y); o[4] = bflo(w.z); o[5] = bfhi(w.z); o[6] = bflo(w.w); o[7] = bfhi(w.w); }
__device__ __forceinline__ void conv_phase(const bf16_t* __restrict__ ZC, const float* __restrict__ cw, const float* __restrict__ cb, bf16_t* __restrict__ Y, int gtid, int gthreads) {
    for (int item = gtid; item < (T_TOK / 16) * 32; item += gthreads) {
        const int ch = item & 31, rb = item >> 5, t0 = rb * 16, c0 = ch * 8;
        float w0[8], w1[8], w2[8], bb[8];
#pragma unroll
        for (int e = 0; e < 8; ++e) { w0[e] = cw[c0 + e]; w1[e] = cw[256 + c0 + e]; w2[e] = cw[512 + c0 + e]; bb[e] = cb[c0 + e]; }
        float zp[8], zc[8], zn[8];
        {
            if ((t0 & (SEQ - 1)) != 0) { float x[8], g[8]; unpack8(*(const u32x4*)(ZC + (size_t)(t0 - 1) * 768 + c0), x); unpack8(*(const u32x4*)(ZC + (size_t)(t0 - 1) * 768 + 512 + c0), g);
#pragma unroll
                for (int e = 0; e < 8; ++e) zp[e] = x[e] * g[e]; }
            else {
#pragma unroll
                for (int e = 0; e < 8; ++e) zp[e] = 0.f; }
            float x[8], g[8]; unpack8(*(const u32x4*)(ZC + (size_t)t0 * 768 + c0), x); unpack8(*(const u32x4*)(ZC + (size_t)t0 * 768 + 512 + c0), g);
#pragma unroll
            for (int e = 0; e < 8; ++e) zc[e] = x[e] * g[e];
        }
        for (int i = 0; i < 16; ++i) {
            const int t = t0 + i;
            if (((t + 1) & (SEQ - 1)) != 0) { float x[8], g[8]; unpack8(*(const u32x4*)(ZC + (size_t)(t + 1) * 768 + c0), x); unpack8(*(const u32x4*)(ZC + (size_t)(t + 1) * 768 + 512 + c0), g);
#pragma unroll
                for (int e = 0; e < 8; ++e) zn[e] = x[e] * g[e]; }
            else {
#pragma unroll
                for (int e = 0; e < 8; ++e) zn[e] = 0.f; }
            float gbv[8]; unpack8(*(const u32x4*)(ZC + (size_t)t * 768 + 256 + c0), gbv);
            float o[8];
#pragma unroll
            for (int e = 0; e < 8; ++e) o[e] = gbv[e] * (w0[e] * zp[e] + w1[e] * zc[e] + w2[e] * zn[e] + bb[e]);
            u32x4 w; w.x = cvtpk(o[0], o[1]); w.y = cvtpk(o[2], o[3]); w.z = cvtpk(o[4], o[5]); w.w = cvtpk(o[6], o[7]);
            *(u32x4*)(Y + (size_t)t * DM + c0) = w;
#pragma unroll
            for (int e = 0; e < 8; ++e) { zp[e] = zc[e]; zc[e] = zn[e]; }
        }
    }
}

__device__ __forceinline__ int lane_id() { int l; asm volatile("v_mbcnt_lo_u32_b32 %0, -1, 0\n\tv_mbcnt_hi_u32_b32 %0, -1, %0" : "=v"(l)); return l; }
#define MFMA32(a, b, c) __builtin_amdgcn_mfma_f32_32x32x16_bf16((a), (b), (c), 0, 0, 0)
__device__ __forceinline__ int crow(int i, int h) { return (i & 3) + 8 * (i >> 2) + 4 * h; }
template <int S> __device__ __forceinline__ bf16x8 packstep(const f32x16& x) {
    u32x4 p; p.x = cvtpk(x[8 * S], x[8 * S + 1]); p.y = cvtpk(x[8 * S + 2], x[8 * S + 3]); p.z = cvtpk(x[8 * S + 4], x[8 * S + 5]); p.w = cvtpk(x[8 * S + 6], x[8 * S + 7]);
    return __builtin_bit_cast(bf16x8, p);
}
typedef short v4i16_t __attribute__((ext_vector_type(4)));
__device__ __forceinline__ s16x4 tr_read(LAS unsigned char* p) { return __builtin_bit_cast(s16x4, __builtin_amdgcn_ds_read_tr16_b64_v4i16((LAS v4i16_t*)p)); }

constexpr int GM_PITCH = 272;
__device__ __forceinline__ void gmlp_phase(LAS unsigned char* lds, const bf16_t* __restrict__ U, const bf16_t* __restrict__ V, const float* __restrict__ PV, const float* __restrict__ gng,
                                           const bf16_t* __restrict__ WS, const float* __restrict__ bias, bf16_t* __restrict__ Y, int gw, int NGW, int wave, int lane) {
    LAS unsigned char* vt = lds + wave * (64 * GM_PITCH);
    const int r = lane & 31, hh = lane >> 5;
    for (int unit = gw; unit < 2048; unit += NGW) {
        const int g = unit & 3, bc = unit >> 2; const size_t row0 = (size_t)bc * 128;
        {
            const int ch = lane & 7; float gn[8];
#pragma unroll
            for (int e = 0; e < 8; ++e) gn[e] = gng[g * 64 + ch * 8 + e];
#pragma unroll 4
            for (int it = 0; it < 16; ++it) {
                const int q = it * 8 + (lane >> 3);
                const f32x4 p = *(const f32x4*)(PV + (row0 + q) * 4);
                const float rstd = 1.0f / sqrtf(((p[0] + p[1]) + (p[2] + p[3])) * (1.0f / 256.0f) + EPS);
                float x[8]; unpack8(*(const u32x4*)(V + (row0 + q) * 256 + g * 64 + ch * 8), x);
#pragma unroll
                for (int e = 0; e < 8; ++e) *(LAS unsigned short*)(vt + (ch * 8 + e) * GM_PITCH + q * 2) = f2bf(x[e] * rstd * gn[e]);
            }
        }
        asm volatile("s_waitcnt lgkmcnt(0)" ::: "memory");
        bf16x8 bfr[2][8];
#pragma unroll
        for (int dt = 0; dt < 2; ++dt)
#pragma unroll
            for (int ks = 0; ks < 8; ++ks) bfr[dt][ks] = *(LAS bf16x8*)(vt + (32 * dt + r) * GM_PITCH + (16 * ks + 8 * hh) * 2);
#pragma unroll 1
        for (int pt = 0; pt < 4; ++pt) {
            f32x16 o0 = {}, o1 = {};
            const bf16_t* wp = WS + ((size_t)(g * 128 + 32 * pt + r)) * 128 + 8 * hh;
#pragma unroll
            for (int ks = 0; ks < 8; ++ks) { const bf16x8 af = *(const bf16x8*)(wp + 16 * ks); o0 = MFMA32(bfr[0][ks], af, o0); o1 = MFMA32(bfr[1][ks], af, o1); }
            { const int pp = 32 * pt + r; const float bs = bias[g * 128 + pp];
              const bf16_t* up = U + (row0 + pp) * 256 + g * 64 + 4 * hh; bf16_t* yp = Y + (row0 + pp) * DM + 768 + g * 64 + 4 * hh;
#pragma unroll
              for (int q4 = 0; q4 < 4; ++q4) {
                  const u32x2 u0 = *(const u32x2*)(up + 8 * q4), u1 = *(const u32x2*)(up + 32 + 8 * q4);
                  u32x2 w0, w1;
                  w0.x = cvtpk(bflo(u0.x) * (o0[4 * q4] + bs), bfhi(u0.x) * (o0[4 * q4 + 1] + bs)); w0.y = cvtpk(bflo(u0.y) * (o0[4 * q4 + 2] + bs), bfhi(u0.y) * (o0[4 * q4 + 3] + bs));
                  w1.x = cvtpk(bflo(u1.x) * (o1[4 * q4] + bs), bfhi(u1.x) * (o1[4 * q4 + 1] + bs)); w1.y = cvtpk(bflo(u1.y) * (o1[4 * q4 + 2] + bs), bfhi(u1.y) * (o1[4 * q4 + 3] + bs));
                  *(u32x2*)(yp + 8 * q4) = w0; *(u32x2*)(yp + 32 + 8 * q4) = w1; } }
        }
        asm volatile("s_waitcnt lgkmcnt(0)" ::: "memory");
    }
}

__device__ __forceinline__ float xhalf_max(float m) { float a = m, b = m; asm volatile("v_nop\n\tv_nop\n\tv_permlane32_swap_b32 %0, %1" : "+v"(a), "+v"(b)); return fmaxf(a, b); }
__device__ __forceinline__ float xhalf_sum(float m) { float a = m, b = m; asm volatile("v_nop\n\tv_nop\n\tv_permlane32_swap_b32 %0, %1" : "+v"(a), "+v"(b)); return a + b; }
constexpr int AT_KP = 208, AT_VP = 144, AT_KB = 64 * AT_KP, AT_VB = 64 * AT_VP, AT_STAGE = AT_KB + AT_VB;
constexpr int AT_WSF = 2 * AT_STAGE, AT_QOFF = AT_WSF + 8 * 64 * 4, AT_QW = 64 * 192;
static_assert(AT_QOFF + 8 * AT_QW <= LDS_BYTES - 64, "attention LDS map");
#define FMAX2(a, b) __builtin_amdgcn_fmed3f((a), (b), __builtin_inff())
#define AT_SOFTMAX(s0, s1, m_run, l_run, oA, oB, wsfp) do { \
        float tmax = FMAX2(s0[0], s1[0]); \
        _Pragma("unroll") for (int i = 1; i < 16; ++i) tmax = FMAX2(tmax, FMAX2(s0[i], s1[i])); \
        tmax = xhalf_max(tmax); \
        if (__any(tmax > m_run + 8.0f)) { \
            const float m_new = fmaxf(m_run, tmax); const float f = __builtin_amdgcn_exp2f(m_run - m_new); m_run = m_new; l_run *= f; \
            if (hh == 0) (wsfp)[r] = f; \
            asm volatile("s_waitcnt lgkmcnt(0)" ::: "memory"); \
            _Pragma("unroll") for (int i = 0; i < 16; ++i) { const float fi = ((wsfp) + 4 * hh)[(i & 3) + 8 * (i >> 2)]; oA[i] *= fi; oB[i] *= fi; } \
        } \
        const f32x2 mm_ = {m_run, m_run}; f32x2 ps2_ = {0.f, 0.f}; \
        _Pragma("unroll") for (int i = 0; i < 16; i += 2) {   \
            const f32x2 d0_ = (f32x2){s0[i], s0[i + 1]} - mm_, d1_ = (f32x2){s1[i], s1[i + 1]} - mm_; \
            s0[i] = __builtin_amdgcn_exp2f(d0_.x); s0[i + 1] = __builtin_amdgcn_exp2f(d0_.y); s1[i] = __builtin_amdgcn_exp2f(d1_.x); s1[i + 1] = __builtin_amdgcn_exp2f(d1_.y); \
            ps2_ += (f32x2){s0[i], s0[i + 1]}; ps2_ += (f32x2){s1[i], s1[i + 1]}; } \
        l_run += ps2_.x + ps2_.y; } while (0)

__device__ __forceinline__ void attn_phase(LAS unsigned char* lds, const bf16_t* __restrict__ Q, const bf16_t* __restrict__ KV, const bf16_t* __restrict__ KR, bf16_t* __restrict__ Y, int vcu, int G, const int tid) {
    const int lane = tid & 63, wid = __builtin_amdgcn_readfirstlane(tid >> 6), r = lane & 31, hh = lane >> 5;
    const int srow = tid >> 3, sch = tid & 7, rrow = (tid >> 2) & 63, rch = tid & 3;
    LAS float* wsf = (LAS float*)(lds + AT_WSF) + wid * 64;
    LAS unsigned char* qimg = lds + AT_QOFF + wid * AT_QW;
    const int i16 = lane & 15, tq = i16 >> 2, tp = i16 & 3, blk = (lane >> 4) & 1;
    const int voff = (4 * hh + tq) * AT_VP + blk * 32 + tp * 8;
    const int qsw = (r >> 2) & 3;
    for (int bh = vcu; bh < 256; bh += G) {
        const int b = bh >> 3, h = bh & 7; const size_t rowbase = (size_t)b * SEQ;
        const bf16_t* kvsrc = KV + (rowbase + srow) * NKV + h * 128 + sch * 8;
        const bf16_t* krsrc = KR + (rowbase + rrow) * 32 + rch * 8;
#pragma unroll 1
        for (int qb = 0; qb < 4; ++qb) {
            {
                const bf16_t* qsrc = Q + (rowbase + qb * 512 + wid * 64 + lane) * NQ + h * 96;
                const int key = (lane >> 2) & 3;
#pragma unroll
                for (int bq = 0; bq < 4; ++bq) { LAS unsigned char* dst = qimg + lane * 192 + ((bq ^ key) << 4);
#pragma unroll
                    for (int aq = 0; aq < 3; ++aq) *(LAS u32x4*)(dst + 64 * aq) = *(const u32x4*)(qsrc + (4 * aq + bq) * 8); }
            }
            u32x4 gk = *(const u32x4*)(kvsrc), gv = *(const u32x4*)(kvsrc + 64), gr = (u32x4){0u, 0u, 0u, 0u};
            if (tid < 256) gr = *(const u32x4*)(krsrc);
            float ma = -1e30f, la = 0.f, mb = -1e30f, lb = 0.f; f32x16 oa0 = {}, oa1 = {}, ob0 = {}, ob1 = {};
#pragma unroll 1
            for (int t = 0; t < SEQ / 64; ++t) {
                LAS unsigned char* kb = lds + (t & 1) * AT_STAGE; LAS unsigned char* vb = kb + AT_KB;
                *(LAS u32x4*)(kb + srow * AT_KP + sch * 16) = gk;
                *(LAS u32x4*)(vb + srow * AT_VP + sch * 16) = gv;
                if (tid < 256) *(LAS u32x4*)(kb + rrow * AT_KP + 128 + rch * 16) = gr;
                __syncthreads();
                if (t + 1 < SEQ / 64) { const size_t adv = (size_t)(t + 1) * 64;
                    gk = *(const u32x4*)(kvsrc + adv * NKV); gv = *(const u32x4*)(kvsrc + adv * NKV + 64);
                    if (tid < 256) gr = *(const u32x4*)(krsrc + adv * 32); }
                f32x16 sa0 = {}, sa1 = {}, sb0 = {}, sb1 = {};
#pragma unroll
                for (int ks = 0; ks < 6; ++ks) {
                    const bf16x8 k0 = *(LAS bf16x8*)(kb + r * AT_KP + ks * 32 + hh * 16);
                    const bf16x8 k1 = *(LAS bf16x8*)(kb + (32 + r) * AT_KP + ks * 32 + hh * 16);
                    const int qc = ((2 * ks + hh) ^ qsw) << 4;
                    const bf16x8 qa = *(LAS bf16x8*)(qimg + r * 192 + qc);
                    const bf16x8 qb2 = *(LAS bf16x8*)(qimg + (32 + r) * 192 + qc);
                    sa0 = MFMA32(k0, qa, sa0); sa1 = MFMA32(k1, qa, sa1);
                    sb0 = MFMA32(k0, qb2, sb0); sb1 = MFMA32(k1, qb2, sb1);
                }
                AT_SOFTMAX(sa0, sa1, ma, la, oa0, oa1, wsf);
                const bf16x8 pa00 = packstep<0>(sa0), pa01 = packstep<1>(sa0), pa10 = packstep<0>(sa1), pa11 = packstep<1>(sa1);
                AT_SOFTMAX(sb0, sb1, mb, lb, ob0, ob1, wsf + 32);
                const bf16x8 pb00 = packstep<0>(sb0), pb01 = packstep<1>(sb0), pb10 = packstep<0>(sb1), pb11 = packstep<1>(sb1);
#define PVSTEP(pa, pb, kv0) do { \
                    const s16x4 l0 = tr_read(vb + (kv0) * AT_VP + voff), h0 = tr_read(vb + ((kv0) + 8) * AT_VP + voff); \
                    const s16x4 l1 = tr_read(vb + (kv0) * AT_VP + voff + 64), h1 = tr_read(vb + ((kv0) + 8) * AT_VP + voff + 64); \
                    const bf16x8 v0 = __builtin_shufflevector(l0, h0, 0, 1, 2, 3, 4, 5, 6, 7), v1 = __builtin_shufflevector(l1, h1, 0, 1, 2, 3, 4, 5, 6, 7); \
                    oa0 = MFMA32(pa, v0, oa0); oa1 = MFMA32(pa, v1, oa1); ob0 = MFMA32(pb, v0, ob0); ob1 = MFMA32(pb, v1, ob1); } while (0)
                PVSTEP(pa00, pb00, 0); PVSTEP(pa01, pb01, 16); PVSTEP(pa10, pb10, 32); PVSTEP(pa11, pb11, 48);
#undef PVSTEP
            }
            const float lta = xhalf_sum(la), ltb = xhalf_sum(lb);
            if (hh == 0) { wsf[r] = 1.0f / lta; wsf[32 + r] = 1.0f / ltb; }
            asm volatile("s_waitcnt lgkmcnt(0)" ::: "memory");
            bf16_t* yp = Y + (rowbase + qb * 512 + wid * 64 + 4 * hh) * DM + 256 + h * 64 + r;
            asm volatile("" : "+v"(yp));
            LAS float* wsfh = wsf + 4 * hh;
#pragma unroll
            for (int i = 0; i < 16; ++i) { const int q = (i & 3) + 8 * (i >> 2); const float fa = wsfh[q], fb = wsfh[32 + q];
                yp[(size_t)q * DM] = f2bf(oa0[i] * fa); yp[(size_t)q * DM + 32] = f2bf(oa1[i] * fa);
                yp[(size_t)(32 + q) * DM] = f2bf(ob0[i] * fb); yp[(size_t)(32 + q) * DM + 32] = f2bf(ob1[i] * fb); }
            __syncthreads();
        }
    }
}

#define XB_TMO      128
#define XB_XCNT(j)  (256  + 64 * (j))
#define XB_XSUB(j)  (1280 + 64 * (j))
#define XB_XGEN(j)  (2304 + 64 * (j))
#define XB_TOP      3328
#define XB_TOPGEN   3392
#define XCD_BAR_WORDS 3456
#define XB_SPIN_CAP (1u << 18)

__device__ __forceinline__ unsigned xb_ld(unsigned* p)              { return __hip_atomic_load(p, __ATOMIC_RELAXED, __HIP_MEMORY_SCOPE_AGENT); }
__device__ __forceinline__ unsigned xb_add(unsigned* p, unsigned v) { return __hip_atomic_fetch_add(p, v, __ATOMIC_RELAXED, __HIP_MEMORY_SCOPE_AGENT); }
__device__ __forceinline__ unsigned xb_xcc_id() { return (unsigned)__builtin_amdgcn_s_getreg((3 << 11) | 20) & 0xFu; }
#define XB_SPIN(cond, bar) do { unsigned _sp = 0; while (cond) { __builtin_amdgcn_s_sleep(1); \
    if ((++_sp & 255u) == 0u) { if (xb_ld(&(bar)[XB_TMO])) break; if (_sp > XB_SPIN_CAP) { atomicAdd(&(bar)[XB_TMO], 1u); break; } } } } while (0)

struct XcdBarrier {
    unsigned* bar; unsigned x;
    volatile LAS unsigned* st;
};

__device__ __forceinline__ XcdBarrier xcd_barrier_post(unsigned* bar, volatile LAS unsigned* st) {
    XcdBarrier b; b.bar = bar; b.x = xb_xcc_id(); b.st = st;
    if (threadIdx.x == 0) (void)xb_add(&bar[XB_XCNT(b.x)], 1u);
    return b;
}
__device__ __forceinline__ void xcd_barrier_complete(unsigned* bar, unsigned x, unsigned& nloc, unsigned& nx) {
    const unsigned G = gridDim.x * gridDim.y * gridDim.z;
    unsigned sum, cnt, mine, sp = 0u;
    for (;;) {
        sum = 0u; cnt = 0u; mine = 0u;
#pragma unroll
        for (unsigned j = 0; j < 16; ++j) { const unsigned c = xb_ld(&bar[XB_XCNT(j)]); sum += c; cnt += (c > 0u) ? 1u : 0u; mine = (j == x) ? c : mine; }
        if (sum == G) break;
        __builtin_amdgcn_s_sleep(1);
        if ((++sp & 255u) == 0u) { if (xb_ld(&bar[XB_TMO])) break; if (sp > XB_SPIN_CAP) { atomicAdd(&bar[XB_TMO], 1u); break; } }
    }
    nloc = mine > 0u ? mine : 1u; nx = cnt > 0u ? cnt : 1u;
}

__device__ __forceinline__ void xcd_barrier(const XcdBarrier& b) {
    asm volatile("s_waitcnt vmcnt(0)" ::: "memory");
    __syncthreads();
    if (threadIdx.x == 0) {
        unsigned* bar = b.bar;
        __builtin_amdgcn_s_waitcnt(0);
        unsigned nloc = b.st[0], nx = b.st[1];
        if (nloc == 0u) { xcd_barrier_complete(bar, b.x, nloc, nx); b.st[0] = nloc; b.st[1] = nx; }
        const unsigned old = xb_add(&bar[XB_XSUB(b.x)], 1u);
        const unsigned gen = old / nloc;
        if (old + 1u == (gen + 1u) * nloc) {
            __builtin_amdgcn_fence(__ATOMIC_RELEASE, "agent");
            asm volatile("s_waitcnt vmcnt(0)" ::: "memory");
            const unsigned og = xb_add(&bar[XB_TOP], 1u);
            const unsigned tg = og / nx;
            if (og + 1u == (tg + 1u) * nx) xb_add(&bar[XB_TOPGEN], 1u);
            else XB_SPIN(xb_ld(&bar[XB_TOPGEN]) == tg, bar);
            __builtin_amdgcn_fence(__ATOMIC_ACQUIRE, "agent");
            xb_add(&bar[XB_XGEN(b.x)], 1u);
            asm volatile("s_waitcnt vmcnt(0)" ::: "memory");
        } else {
            XB_SPIN(xb_ld(&bar[XB_XGEN(b.x)]) == gen, bar);
            __builtin_amdgcn_fence(__ATOMIC_ACQUIRE, "agent");
            asm volatile("s_waitcnt vmcnt(0)" ::: "memory");
        }
    }
    __syncthreads();
}


#ifndef REP_CONV
#define REP_CONV 1
#endif
#ifndef REP_GMLP
#define REP_GMLP 1
#endif
#ifndef REP_PRO
#define REP_PRO 1
#endif
#ifndef REP_RP
#define REP_RP 1
#endif
#ifndef REP_GU
#define REP_GU 1
#endif
#ifndef REP_DN
#define REP_DN 1
#endif
#ifndef REP_WIN
#define REP_WIN 1
#endif
#ifndef REP_MIX2
#define REP_MIX2 1
#endif
#define GEMM_CALL(EpiT, E, Aptr, Bptr, Mv, Nv, Kv) do { pg8::Gemm g_{(Aptr), (Bptr), (Mv), (Nv), (Kv)}; pg8::StaticOrder S_; S_.init((Mv), (Nv), G, (int)blockIdx.x); \
        int l_o_ = lane_id(); asm volatile("" : "+v"(l_o_)); pg8::gemm_phase<EpiT, pg8::StaticOrder, true, true>(lds, g_, S_, (E), wave * 64 + l_o_); __syncthreads(); } while (0)

__global__ void __launch_bounds__(NTHR, 2) mk_fwd(Args a) {
    extern __shared__ __attribute__((aligned(16))) unsigned char lds_raw[];
    LAS unsigned char* lds = (LAS unsigned char*)lds_raw;
    cg::grid_group grid = cg::this_grid();
    const int wave = __builtin_amdgcn_readfirstlane((int)threadIdx.x >> 6);
    const int G = gridDim.x, bx = blockIdx.x, vcu = (G % 8 == 0) ? (bx % 8) * (G / 8) + bx / 8 : bx;
    const int gw = vcu * NWAVES + wave, NGW = G * NWAVES, gthreads = G * NTHR;
    unsigned char* const ws_k = a.ws;
#define rope ((float*)(ws + WS_ROPE))
#define PQ ((float*)(ws + WS_PQ))
#define PKV ((float*)(ws + WS_PKV))
#define PV ((float*)(ws + WS_PV))
#define RSv ((float*)(ws + WS_RS))
#define XN ((bf16_t*)(ws + WS_XN))
#define ACT ((bf16_t*)(ws + WS_ACT))
#define ZC ((bf16_t*)(ws + WS_ZC))
#define CQ ((bf16_t*)(ws + WS_CQ))
#define Ub ((bf16_t*)(ws + WS_U))
#define Vb ((bf16_t*)(ws + WS_V))
#define CKV ((bf16_t*)(ws + WS_CKV))
#define KR ((bf16_t*)(ws + WS_KR))
#define Qb ((bf16_t*)(ws + WS_Q))
#define KVb ((bf16_t*)(ws + WS_KV))
#define Yb ((bf16_t*)(ws + WS_Y))
#define Hb ((bf16_t*)(ws + WS_H))
    float* X = a.out;
    volatile LAS unsigned* misc = (volatile LAS unsigned*)(lds + LDS_BYTES - 64);
    if (threadIdx.x < 2) misc[threadIdx.x] = 0u;
    if (bx == 0) { for (int i = threadIdx.x; i < XCD_BAR_WORDS; i += NTHR) ((unsigned*)(a.ws + 65536))[i] = 0u; }
    XcdBarrier xbar; xbar.bar = (unsigned*)(a.ws + 65536); xbar.x = 0; xbar.st = misc;
    int ph = 0;
    const int lo = a.ph_lo, hi = a.ph_hi;
#define RUN (ph >= lo && ph < hi)
#define OPAQUE_IDS unsigned long long wsv_ = (unsigned long long)ws_k; asm volatile("" : "+s"(wsv_)); unsigned char* ws = (unsigned char*)(__attribute__((address_space(1))) unsigned char*)wsv_; int lane_o_ = lane_id(); asm volatile("" : "+v"(lane_o_)); const int tid = wave * 64 + lane_o_; const int lane = tid & 63, gtid = bx * NTHR + tid; (void)lane; (void)gtid;
#define SEAM do { if (ph >= lo && ph + 1 < hi) { if (ph == 0) { grid.sync(); xbar = xcd_barrier_post((unsigned*)(a.ws + 65536), misc); } else xcd_barrier(xbar); } ++ph; } while (0)

    if (RUN) { OPAQUE_IDS
#ifndef NO_PRO
        _Pragma("unroll 1") for (int rr_ = 0; rr_ < REP_PRO; ++rr_) prologue_weights(a, ws, lds, gw, NGW, wave, lane);
#endif
        rope_table(rope, gtid, gthreads);
        row_pass(a.in[0], nullptr, nullptr, 0.f, nullptr, nullptr, XN, RSv, gw, NGW, lane);
    }
    SEAM;

#pragma unroll 1
    for (int sb = 0; sb < 6; ++sb) {
        const int l = sb / 3, kind = sb % 3;
        if (kind != 1) {
            #ifndef NO_GU
            _Pragma("unroll 1") for (int rep_ = 0; rep_ < REP_GU; ++rep_)
            if (RUN) { OPAQUE_IDS EpiSwiGLU E{ACT, RSv}; GEMM_CALL(EpiSwiGLU, E, XN, wptr(ws, l, kind == 0 ? OFF_GU1 : OFF_GU2), T_TOK, NGU, DM); }
#endif
            SEAM;
            #ifndef NO_DN
            _Pragma("unroll 1") for (int rep_ = 0; rep_ < REP_DN; ++rep_)
#ifdef PROBE_SPLIT_DN
            _Pragma("unroll 1") for (int half_ = 0; half_ < 2; ++half_) { OPAQUE_IDS EpiPlain E{Hb, DM};
                { pg8::Gemm g_{ACT, wptr(ws, l, kind == 0 ? OFF_DN1 : OFF_DN2), T_TOK, DM, DFF}; pg8::StaticOrder S_; S_.init(T_TOK, DM, G, (int)blockIdx.x); S_.i0 = 2 * half_; S_.iend = 2 * half_ + 2;
                  int l_o_ = lane_id(); asm volatile("" : "+v"(l_o_)); pg8::gemm_phase<EpiPlain, pg8::StaticOrder, true, true>(lds, g_, S_, E, wave * 64 + l_o_); __syncthreads(); }
                if (half_ == 0) xcd_barrier(xbar); }
#else
            if (RUN) { OPAQUE_IDS EpiPlain E{Hb, DM}; GEMM_CALL(EpiPlain, E, ACT, wptr(ws, l, kind == 0 ? OFF_DN1 : OFF_DN2), T_TOK, DM, DFF); }
#endif
#endif
            SEAM;
            if (RUN) { OPAQUE_IDS
                const float* gpost = a.in[kind == 0 ? 4 : 21] + l * DM;
                if (sb == 0) { _Pragma("unroll 1") for (int rr_ = 0; rr_ < REP_RP; ++rr_) row_pass(a.in[0], nullptr, Hb, 0.5f, gpost, nullptr, XN, RSv, gw, NGW, lane); }
                else if (sb == 5) row_pass(nullptr, XN, Hb, 0.5f, gpost, X, nullptr, RSv, gw, NGW, lane);
                else row_pass(nullptr, XN, Hb, 0.5f, gpost, nullptr, XN, RSv, gw, NGW, lane);
            }
            SEAM;
        } else {
            #ifndef NO_WIN
            _Pragma("unroll 1") for (int rep_ = 0; rep_ < REP_WIN; ++rep_)
            if (RUN) { OPAQUE_IDS EpiWin E{ZC, CQ, Ub, Vb, CKV, KR, PQ, PV, PKV, rope, RSv}; GEMM_CALL(EpiWin, E, XN, wptr(ws, l, OFF_IN), T_TOK, NIN_P, DM); }
#endif
            SEAM;
            _Pragma("unroll 1") for (int rep_ = 0; rep_ < REP_MIX2; ++rep_)
            if (RUN) { OPAQUE_IDS
#ifndef NO_UQ
                { EpiUq E{Qb, PQ, rope}; GEMM_CALL(EpiUq, E, CQ, wptr(ws, l, OFF_UQ), T_TOK, NQ, 256); }
#endif
#ifndef NO_UKV
                { EpiUkv E{KVb, PKV}; GEMM_CALL(EpiUkv, E, CKV, wptr(ws, l, OFF_UKV), T_TOK, NKV, 128); }
#endif
#ifndef NO_CONV
                _Pragma("unroll 1") for (int rc_ = 0; rc_ < REP_CONV; ++rc_) { OPAQUE_IDS conv_phase(ZC, a.in[7] + l * 768, a.in[8] + l * 256, Yb, gtid, gthreads); }
#endif
#ifndef NO_GMLP
                _Pragma("unroll 1") for (int rg_ = 0; rg_ < REP_GMLP; ++rg_) { OPAQUE_IDS gmlp_phase(lds, Ub, Vb, PV, a.in[13] + l * 256, wptr(ws, l, OFF_GWS), a.in[15] + l * 512, Yb, gw, NGW, wave, lane); }
#endif
            }
            SEAM;
#ifndef NO_ATTN
            if (RUN) { OPAQUE_IDS attn_phase(lds, Qb, KVb, KR, Yb, vcu, G, tid); }
#ifdef PROBE_DUP_ATTN
            if (RUN) { __syncthreads(); OPAQUE_IDS attn_phase(lds, Qb, KVb, KR, Yb, vcu, G, tid); }
#endif
#endif
            SEAM;
#ifndef NO_OUT
            _Pragma("unroll 1") for (int rep_ = 0; rep_ < REP_WIN; ++rep_)
            if (RUN) { OPAQUE_IDS EpiPlain E{Hb, DM}; GEMM_CALL(EpiPlain, E, Yb, wptr(ws, l, OFF_OUT), T_TOK, DM, DM); }
#endif
            SEAM;
            if (RUN) { OPAQUE_IDS row_pass(nullptr, XN, Hb, 1.0f, a.in[17] + l * DM, nullptr, XN, RSv, gw, NGW, lane); }
            SEAM;
        }
    }
}
constexpr int N_PHASES = 1 + 2 * (3 + 5 + 3);

#ifndef MK_SPLIT
#define MK_SPLIT 0
#endif
extern "C" void kernel_launch(void* const* d_in, const int* in_sizes, int n_in, void* d_out, int out_size, void* d_ws, size_t ws_size, hipStream_t stream) {
    static int grid = 0;
    if (grid == 0) {
        if (n_in != 22 || out_size != T_TOK * DM || ws_size < WS_END) { fprintf(stderr, "kernel_launch: unexpected shapes n_in %d out %d ws %zu\n", n_in, out_size, ws_size); grid = -1; return; }
        int dev = 0, cus = 0, per_cu = 0;
        (void)hipGetDevice(&dev); (void)hipDeviceGetAttribute(&cus, hipDeviceAttributeMultiprocessorCount, dev);
        if (hipFuncSetAttribute((const void*)mk_fwd, hipFuncAttributeMaxDynamicSharedMemorySize, LDS_BYTES) != hipSuccess) { fprintf(stderr, "kernel_launch: hipFuncSetAttribute failed\n"); grid = -1; return; }
        if (hipOccupancyMaxActiveBlocksPerMultiprocessor(&per_cu, (const void*)mk_fwd, NTHR, LDS_BYTES) != hipSuccess || per_cu < 1) { fprintf(stderr, "kernel_launch: occupancy query says %d\n", per_cu); per_cu = 1; }
        (void)hipGetLastError();
        grid = cus * per_cu;
        if (grid > cus) grid = cus;
    }
    if (grid < 0) return;
    Args a{};
    for (int i = 0; i < 22; ++i) a.in[i] = (const float*)d_in[i];
    a.out = (float*)d_out; a.ws = (unsigned char*)d_ws;
#if MK_SPLIT
    for (int p = 0; p < N_PHASES; ++p) { a.ph_lo = p; a.ph_hi = p + 1; hipLaunchKernelGGL(mk_fwd, dim3(grid), dim3(NTHR), LDS_BYTES, stream, a); }
#else
    a.ph_lo = 0; a.ph_hi = N_PHASES;
    void* args[] = {&a};
    hipError_t e = hipLaunchCooperativeKernel((const void*)mk_fwd, dim3(grid), dim3(NTHR), args, LDS_BYTES, stream);
    if (e != hipSuccess) fprintf(stderr, "cooperative launch failed: %s (grid %d)\n", hipGetErrorString(e), grid);
#endif
}
```

```cpp
#include <hip/hip_runtime.h>
#include <hip/hip_cooperative_groups.h>
#include <cstdio>
#include <cstdint>
namespace cg = cooperative_groups;
namespace pg8 {
#define PG8_LAS __attribute__((address_space(3)))
typedef unsigned short bf16_t;
typedef short bf16x8 __attribute__((ext_vector_type(8)));
typedef float f32x4 __attribute__((ext_vector_type(4)));
typedef unsigned u32x4 __attribute__((ext_vector_type(4)));
constexpr int BM = 256, BK = 64, HALF = 128, HTB = HALF * BK * 2  , STAGE_BYTES = 8 * HTB, NXCD = 8, WGM = 8;

__host__ __device__ __forceinline__ int lds_byte(int r, int c) { const int st = (r >> 4) * 2 + (c >> 5), rr = r & 15, cc = c & 31, ob = rr * 64 + cc * 2; return st * 1024 + (ob ^ (((ob >> 9) & 1) << 5)); }
__host__ __device__ __forceinline__ void stage_rc(int b, int& R, int& C) { const int st = b / 1024, sb = b % 1024, swz = sb ^ (((sb >> 9) & 1) << 5); R = (st >> 1) * 16 + swz / 64; C = (st & 1) * 32 + (swz % 64) / 2; }
__host__ __device__ __forceinline__ int perm32(int rho) { const int n = rho >> 4, i = rho & 15; return 8 * (i >> 2) + 4 * n + (i & 3); }

struct Unit { int pm, pn; };
struct Gemm { const bf16_t* A; const bf16_t* Bt; int M, N, K; };

struct StaticOrder {
    int nM, nN, nwg, G, c, i0, iend;
    __host__ __device__ void init(int M, int N, int G_, int c_) { nM = M / BM; nN = N / BM; nwg = nM * nN; G = G_; c = c_; i0 = 0; iend = 1 << 30; }
    __host__ __device__ bool next(int i, Unit& u) const {
        const long L = (long)(i + i0) * G + c; if (i + i0 >= iend || L >= nwg) return false;
        int wgid = (int)L; { const int q = nwg / NXCD, r = nwg % NXCD, xcd = wgid % NXCD, off = wgid / NXCD; wgid = (xcd < r ? xcd * (q + 1) : r * (q + 1) + (xcd - r) * q) + off; }
        const int nig = WGM * nN, gid = wgid / nig, fm = gid * WGM, gsz = (nM - fm) < WGM ? (nM - fm) : WGM;
        u.pm = fm + ((wgid % nig) % gsz); u.pn = (wgid % nig) / gsz; return true;
    }
    __device__ __forceinline__ void a_ready(const Unit&) const {}
    __device__ __forceinline__ void done(const Unit&) const {}
};

__device__ __forceinline__ unsigned cvt_pk_bf16(float lo, float hi) { unsigned r; asm volatile("v_cvt_pk_bf16_f32 %0, %1, %2" : "=v"(r) : "v"(lo), "v"(hi)); return r; }
typedef float f32x2 __attribute__((ext_vector_type(2)));
__device__ __forceinline__ f32x2 gelu_pk(f32x2 v) {
    const f32x2 av = __builtin_elementwise_abs(v), d = av * 0.2316418882f + 1.0f;
    f32x2 t; t.x = __builtin_amdgcn_rcpf(d.x); t.y = __builtin_amdgcn_rcpf(d.y);
    f32x2 q = t * 0.5307027145f + (-0.7265760135f); q = q * t + 0.7107068705f; q = q * t + (-0.142248368f); q = q * t + 0.127414796f; q = q * t;
    const f32x2 s = (v * v) * (-0.72134752044f);
    f32x2 e; e.x = __builtin_amdgcn_exp2f(s.x); e.y = __builtin_amdgcn_exp2f(s.y);
    const f32x2 m = v * (q * e), r = v - m;
    f32x2 o; o.x = v.x < 0.f ? m.x : r.x; o.y = v.y < 0.f ? m.y : r.y; return o;
}
template <class Epi, class Sched, bool ALIGN_EPI = false, bool SP2 = false>
__device__ __forceinline__ void gemm_phase(PG8_LAS unsigned char* lds, const Gemm g, const Sched& S, const Epi& E, const int tid_in) {
    const int tid = tid_in, wid = __builtin_amdgcn_readfirstlane(tid >> 6), lane = tid & 63, wr = wid >> 2, wc = wid & 3, fr = lane & 15, fq = lane >> 4;
    const int K = g.K, nt = K / BK;
    unsigned voffA[2], voffB[2];
#pragma unroll
    for (int i = 0; i < 2; ++i) { int R, C; stage_rc(tid * 16 + i * 8192, R, C); const int Rb = Epi::PERM ? ((R & ~31) + perm32(R & 31)) : R;
        voffA[i] = (unsigned)(R * K + C) * 2u; voffB[i] = (unsigned)(Rb * K + C) * 2u; }
    const size_t kstep = (size_t)(BK * 2);
    const size_t hstep = (size_t)HALF * K * 2;
    const size_t tstep = 2 * hstep;
    const unsigned ldsw = (unsigned)wid * 1024u;
    const int aoff = lds_byte(wr * 64 + fr, fq * 8), boff = lds_byte(wc * 32 + fr, fq * 8);
#define PG8_SA(b, h) (((b) * 2 + (h)) * HTB)
#define PG8_SB(b, h) ((4 + (b) * 2 + (h)) * HTB)
#define PG8_STAGE(bufoff, gbase, voff) do { _Pragma("unroll") for (int _i = 0; _i < 2; ++_i) \
        __builtin_amdgcn_global_load_lds((const unsigned*)((const char*)(gbase) + (voff)[_i]), (PG8_LAS unsigned*)(lds + (bufoff) + ldsw + _i * 8192), 16, 0, 0); } while (0)
#define PG8_LDA(dst, b, h) do { _Pragma("unroll") for (int m = 0; m < 4; ++m) _Pragma("unroll") for (int k = 0; k < 2; ++k) dst[m][k] = *(const PG8_LAS bf16x8*)(lds + PG8_SA(b, h) + aoff + m * 2048 + k * 1024); } while (0)
#define PG8_LDB(dst, b, h) do { _Pragma("unroll") for (int n = 0; n < 2; ++n) _Pragma("unroll") for (int k = 0; k < 2; ++k) dst[n][k] = *(const PG8_LAS bf16x8*)(lds + PG8_SB(b, h) + boff + n * 2048 + k * 1024); } while (0)
#define PG8_MMA(ai, bj, At, Bt) do { __builtin_amdgcn_s_setprio(1); _Pragma("unroll") for (int m = 0; m < 4; ++m) _Pragma("unroll") for (int n = 0; n < 2; ++n) _Pragma("unroll") for (int k = 0; k < 2; ++k) \
        acc[ai][bj][m][n] = __builtin_amdgcn_mfma_f32_16x16x32_bf16(Bt[n][k], At[m][k], acc[ai][bj][m][n], 0, 0, 0); __builtin_amdgcn_s_setprio(0); } while (0)
#define PG8_WAIT_V(n) asm volatile("s_waitcnt vmcnt(" #n ")" ::: "memory")
#define PG8_WAIT_L(n) asm volatile("s_waitcnt lgkmcnt(" #n ")" ::: "memory")
#define PG8_BAR __builtin_amdgcn_s_barrier()
#define PG8_SCHED __builtin_amdgcn_sched_barrier(0)
    Unit cur, nxt; int ui = 0;
    if (!S.next(0, cur)) return;
    f32x4 acc[2][2][4][2];
#pragma unroll
    for (int a = 0; a < 2; ++a)
#pragma unroll
        for (int b = 0; b < 2; ++b)
#pragma unroll
            for (int m = 0; m < 4; ++m)
#pragma unroll
                for (int n = 0; n < 2; ++n) acc[a][b][m][n] = (f32x4){0.f, 0.f, 0.f, 0.f};
    bf16x8 At[4][2], B0[2][2], B1[2][2];
    const char* cA = (const char*)g.A + (size_t)cur.pm * tstep; const char* cB = (const char*)g.Bt + (size_t)cur.pn * tstep;
    S.a_ready(cur);
    if constexpr (SP2) {
        PG8_STAGE(PG8_SB(0, 0), cB, voffB); PG8_STAGE(PG8_SB(0, 1), cB + hstep, voffB); PG8_STAGE(PG8_SA(0, 0), cA, voffA); PG8_STAGE(PG8_SA(0, 1), cA + hstep, voffA);
        if (wr == 1) PG8_BAR;
        PG8_WAIT_V(2); PG8_BAR;
        PG8_STAGE(PG8_SB(1, 0), cB + kstep, voffB); PG8_STAGE(PG8_SA(1, 0), cA + kstep, voffA); PG8_STAGE(PG8_SB(1, 1), cB + hstep + kstep, voffB);
        PG8_WAIT_V(6); PG8_BAR;
    } else {
        PG8_STAGE(PG8_SB(0, 0), cB, voffB); PG8_STAGE(PG8_SA(0, 0), cA, voffA); PG8_STAGE(PG8_SB(0, 1), cB + hstep, voffB); PG8_STAGE(PG8_SA(0, 1), cA + hstep, voffA);
        if (wr == 1) PG8_BAR;
        PG8_WAIT_V(4); PG8_BAR;
        PG8_STAGE(PG8_SB(1, 0), cB + kstep, voffB); PG8_STAGE(PG8_SA(1, 0), cA + kstep, voffA); PG8_STAGE(PG8_SB(1, 1), cB + hstep + kstep, voffB);
        PG8_WAIT_V(6); PG8_BAR;
    }
    for (;;) {
        const bool has_next = S.next(ui + 1, nxt);
        const char* nA = has_next ? (const char*)g.A + (size_t)nxt.pm * tstep : cA; const char* nB = has_next ? (const char*)g.Bt + (size_t)nxt.pn * tstep : cB;
        for (int t = 0; t < nt; t += 2) {
            const bool last = (t == nt - 2);
            const char* a1 = cA + (size_t)(t + 1) * kstep;
            const char* a2 = last ? nA : cA + (size_t)(t + 2) * kstep; const char* b2 = last ? nB : cB + (size_t)(t + 2) * kstep;
            const char* a3 = a2 + kstep; const char* b3 = b2 + kstep;
            if (last && has_next) S.a_ready(nxt);
            if constexpr (SP2) {
            PG8_LDB(B0, 0, 0); PG8_LDB(B1, 0, 1); PG8_SCHED; PG8_LDA(At, 0, 0); PG8_STAGE(PG8_SA(1, 1), a1 + hstep, voffA);
            PG8_WAIT_V(8); PG8_WAIT_L(0); PG8_BAR; PG8_MMA(0, 0, At, B0); PG8_MMA(0, 1, At, B1); PG8_BAR; PG8_SCHED;
            PG8_LDA(At, 0, 1); PG8_STAGE(PG8_SB(0, 0), b2, voffB); PG8_STAGE(PG8_SB(0, 1), b2 + hstep, voffB); PG8_STAGE(PG8_SA(0, 0), a2, voffA);
            PG8_WAIT_V(8); PG8_WAIT_L(0); PG8_BAR; PG8_MMA(1, 0, At, B0); PG8_MMA(1, 1, At, B1); PG8_BAR; PG8_SCHED;
            PG8_LDB(B0, 1, 0); PG8_LDB(B1, 1, 1); PG8_SCHED; PG8_LDA(At, 1, 0); PG8_STAGE(PG8_SA(0, 1), a2 + hstep, voffA);
            PG8_WAIT_V(8); PG8_WAIT_L(0); PG8_BAR; PG8_MMA(0, 0, At, B0); PG8_MMA(0, 1, At, B1); PG8_BAR; PG8_SCHED;
            PG8_LDA(At, 1, 1); PG8_STAGE(PG8_SB(1, 0), b3, voffB); PG8_STAGE(PG8_SB(1, 1), b3 + hstep, voffB); PG8_STAGE(PG8_SA(1, 0), a3, voffA);
            PG8_WAIT_V(8); PG8_WAIT_L(0); PG8_BAR; PG8_MMA(1, 0, At, B0); PG8_MMA(1, 1, At, B1); PG8_BAR; PG8_SCHED;
            } else {
            PG8_LDB(B0, 0, 0); PG8_SCHED; PG8_LDA(At, 0, 0); PG8_STAGE(PG8_SA(1, 1), a1 + hstep, voffA);
            PG8_WAIT_L(8); PG8_BAR; PG8_WAIT_L(0); PG8_MMA(0, 0, At, B0); PG8_BAR; PG8_SCHED;
            PG8_LDB(B1, 0, 1); PG8_STAGE(PG8_SB(0, 0), b2, voffB);
            PG8_BAR; PG8_WAIT_L(0); PG8_MMA(0, 1, At, B1); PG8_BAR;
            PG8_LDA(At, 0, 1); PG8_STAGE(PG8_SA(0, 0), a2, voffA);
            PG8_BAR; PG8_WAIT_L(0); PG8_MMA(1, 0, At, B0); PG8_BAR; PG8_SCHED;
            PG8_STAGE(PG8_SB(0, 1), b2 + hstep, voffB);
            PG8_WAIT_V(6); PG8_BAR; PG8_MMA(1, 1, At, B1); PG8_BAR;
            PG8_LDB(B0, 1, 0); PG8_SCHED; PG8_LDA(At, 1, 0); PG8_STAGE(PG8_SA(0, 1), a2 + hstep, voffA);
            PG8_WAIT_L(8); PG8_BAR; PG8_WAIT_L(0); PG8_MMA(0, 0, At, B0); PG8_BAR; PG8_SCHED;
            PG8_LDB(B1, 1, 1); PG8_STAGE(PG8_SB(1, 0), b3, voffB);
            PG8_BAR; PG8_WAIT_L(0); PG8_MMA(0, 1, At, B1); PG8_BAR;
            PG8_LDA(At, 1, 1); PG8_STAGE(PG8_SA(1, 0), a3, voffA);
            PG8_BAR; PG8_WAIT_L(0); PG8_MMA(1, 0, At, B0); PG8_BAR; PG8_SCHED;
            PG8_STAGE(PG8_SB(1, 1), b3 + hstep, voffB);
            PG8_WAIT_V(6); PG8_BAR; PG8_MMA(1, 1, At, B1); PG8_BAR;
            }
        }
        if constexpr (ALIGN_EPI) { if (wr == 0) PG8_BAR; }
        if constexpr (!Epi::AFTER_DRAIN) { E(acc, cur, wr, wc, fr, fq); S.done(cur); }
        if (!has_next) break;
#pragma unroll
        for (int a = 0; a < 2; ++a)
#pragma unroll
            for (int b = 0; b < 2; ++b)
#pragma unroll
                for (int m = 0; m < 4; ++m)
#pragma unroll
                    for (int n = 0; n < 2; ++n) acc[a][b][m][n] = (f32x4){0.f, 0.f, 0.f, 0.f};
        cur = nxt; cA = nA; cB = nB; ++ui;
        if constexpr (ALIGN_EPI) { if (wr == 1) PG8_BAR; }
    }
    PG8_WAIT_V(0);
    if constexpr (!ALIGN_EPI) { if (wr == 0) PG8_BAR; }
    PG8_BAR;
    if constexpr (Epi::AFTER_DRAIN) { E.fused(acc, cur, wr, wc, fr, fq, lds, wid, lane); S.done(cur); }
#undef PG8_SA
#undef PG8_SB
#undef PG8_STAGE
#undef PG8_LDA
#undef PG8_LDB
#undef PG8_MMA
#undef PG8_WAIT_V
#undef PG8_WAIT_L
#undef PG8_BAR
#undef PG8_SCHED
}
}

#define LAS __attribute__((address_space(3)))
using pg8::f32x4; using pg8::bf16_t; using pg8::Unit; using pg8::u32x4; using pg8::f32x2; using pg8::bf16x8;
typedef float f32x16 __attribute__((ext_vector_type(16)));
typedef short s16x4 __attribute__((ext_vector_type(4)));
typedef unsigned u32x2 __attribute__((ext_vector_type(2)));
typedef __bf16 bf16x2_t __attribute__((ext_vector_type(2)));

constexpr int T_TOK = 65536, SEQ = 2048, DM = 1024, DFF = 2816, NGU = 5632, NIN_P = 1792, NQ = 768, NKV = 1024;
constexpr float EPS = 1e-6f;
constexpr int NWAVES = 8, NTHR = 512;
constexpr int LDS_BYTES = 147456;
constexpr float QSCALE = 0.10206207261596575f * 1.4426950408889634f;

constexpr size_t MiB = 1u << 20;
constexpr size_t WS_ROPE = 1 * MiB;
constexpr size_t WS_PQ = 2 * MiB, WS_PKV = 3 * MiB, WS_PV = 4 * MiB, WS_RS = 5 * MiB;
constexpr size_t WS_W = 8 * MiB, WS_WL = 42 * MiB;
constexpr size_t WS_XN = 96 * MiB;
constexpr size_t WS_ACT = 224 * MiB;
constexpr size_t WS_ZC = 224 * MiB, WS_CQ = 320 * MiB, WS_U = 352 * MiB, WS_V = 384 * MiB, WS_CKV = 416 * MiB, WS_KR = 432 * MiB, WS_Q = 448 * MiB;
constexpr size_t WS_KV = 576 * MiB, WS_Y = 704 * MiB, WS_H = 832 * MiB, WS_END = 960 * MiB;

__device__ __forceinline__ unsigned cvtpk(float lo, float hi) { f32x2 v = {lo, hi}; bf16x2_t b = __builtin_convertvector(v, bf16x2_t); return __builtin_bit_cast(unsigned, b); }
__device__ __forceinline__ u32x4 pack8(f32x4 v0, f32x4 v1) { u32x4 w; w.x = cvtpk(v0[0], v0[1]); w.y = cvtpk(v0[2], v0[3]); w.z = cvtpk(v1[0], v1[1]); w.w = cvtpk(v1[2], v1[3]); return w; }
__device__ __forceinline__ unsigned short f2bf(float f) { unsigned u = __builtin_bit_cast(unsigned, f); return (unsigned short)((u + 0x7fffu + ((u >> 16) & 1u)) >> 16); }
__device__ __forceinline__ float bf2f(unsigned short b) { return __builtin_bit_cast(float, (unsigned)b << 16); }
__device__ __forceinline__ float bflo(unsigned w) { return __builtin_bit_cast(float, w << 16); }
__device__ __forceinline__ float bfhi(unsigned w) { return __builtin_bit_cast(float, w & 0xffff0000u); }
__device__ __forceinline__ float silu_mul(float g, float u) { return g * __builtin_amdgcn_rcpf(1.0f + __builtin_amdgcn_exp2f(-1.4426950408889634f * g)) * u; }
__device__ __forceinline__ f32x4 gelu4(f32x4 v) { f32x2 a = pg8::gelu_pk((f32x2){v[0], v[1]}), b = pg8::gelu_pk((f32x2){v[2], v[3]}); return (f32x4){a.x, a.y, b.x, b.y}; }
__device__ __forceinline__ float sumsq4(f32x4 v) { return (v[0] * v[0] + v[1] * v[1]) + (v[2] * v[2] + v[3] * v[3]); }
__device__ __forceinline__ float shflx(float v, int o, int lane) { return __builtin_bit_cast(float, __builtin_amdgcn_ds_bpermute((lane ^ o) << 2, __builtin_bit_cast(int, v))); }
__device__ __forceinline__ float wave_sum(float v, int lane) {
#pragma unroll
    for (int o = 1; o < 64; o <<= 1) v += shflx(v, o, lane);
    return v;
}

struct EpiPlain {
    static constexpr bool PERM = true, AFTER_DRAIN = false;
    bf16_t* O; int ldc;
    __device__ __forceinline__ void operator()(const f32x4 (&acc)[2][2][4][2], const Unit& u, int wr, int wc, int fr, int fq) const {
        const int row0 = u.pm * 256 + wr * 64 + fr, col0 = u.pn * 256 + wc * 32 + 8 * fq;
#pragma unroll
        for (int ai = 0; ai < 2; ++ai)
#pragma unroll
            for (int m = 0; m < 4; ++m) { bf16_t* rowp = O + (size_t)(row0 + ai * 128 + m * 16) * ldc + col0;
#pragma unroll
                for (int bj = 0; bj < 2; ++bj) *(u32x4*)(rowp + bj * 128) = pack8(acc[ai][bj][m][0], acc[ai][bj][m][1]); }
    }
};
struct EpiSwiGLU {
    static constexpr bool PERM = true, AFTER_DRAIN = false;
    bf16_t* O; const float* RS;
    __device__ __forceinline__ void operator()(const f32x4 (&acc)[2][2][4][2], const Unit& u, int wr, int wc, int fr, int fq) const {
        const int row0 = u.pm * 256 + wr * 64 + fr, col0 = u.pn * 128 + wc * 32 + 8 * fq;
#pragma unroll
        for (int ai = 0; ai < 2; ++ai)
#pragma unroll
            for (int m = 0; m < 4; ++m) {
                const f32x4 g0 = acc[ai][0][m][0], g1 = acc[ai][0][m][1], u0 = acc[ai][1][m][0], u1 = acc[ai][1][m][1];
                f32x4 r0, r1;
#pragma unroll
                for (int e = 0; e < 4; ++e) { r0[e] = silu_mul(g0[e], u0[e]); r1[e] = silu_mul(g1[e], u1[e]); }
                *(u32x4*)(O + (size_t)(row0 + ai * 128 + m * 16) * DFF + col0) = pack8(r0, r1);
            }
    }
};
struct EpiWin {
    static constexpr bool PERM = true, AFTER_DRAIN = false;
    bf16_t *ZC, *CQ, *U, *V, *CKV, *KR; float *PQ, *PV, *PKV; const float* rope; const float* RS;
    __device__ __forceinline__ void operator()(const f32x4 (&acc)[2][2][4][2], const Unit& u, int wr, int wc, int fr, int fq) const {
        const int row0 = u.pm * 256 + wr * 64 + fr, cw = wc * 32 + 8 * fq, pn = u.pn;
        if (pn < 3) {
#pragma unroll
            for (int ai = 0; ai < 2; ++ai)
#pragma unroll
                for (int m = 0; m < 4; ++m) { bf16_t* rowp = ZC + (size_t)(row0 + ai * 128 + m * 16) * 768 + pn * 256 + cw;
#pragma unroll
                    for (int bj = 0; bj < 2; ++bj) *(u32x4*)(rowp + bj * 128) = pack8(acc[ai][bj][m][0], acc[ai][bj][m][1]); }
        } else if (pn == 3) {
#pragma unroll
            for (int ai = 0; ai < 2; ++ai)
#pragma unroll
                for (int m = 0; m < 4; ++m) { const int row = row0 + ai * 128 + m * 16; bf16_t* rowp = CQ + (size_t)row * 256 + cw; float ss = 0.f;
#pragma unroll
                    for (int bj = 0; bj < 2; ++bj) { const f32x4 v0 = acc[ai][bj][m][0], v1 = acc[ai][bj][m][1]; ss += sumsq4(v0) + sumsq4(v1); *(u32x4*)(rowp + bj * 128) = pack8(v0, v1); }
                    ss += shflx(ss, 16, fq * 16 + fr); ss += shflx(ss, 32, fq * 16 + fr);
                    if (fq == 0) PQ[(size_t)row * 4 + wc] = ss; }
        } else if (pn == 4) {
#pragma unroll
            for (int ai = 0; ai < 2; ++ai)
#pragma unroll
                for (int m = 0; m < 4; ++m) { bf16_t* rowp = U + (size_t)(row0 + ai * 128 + m * 16) * 256 + cw;
#pragma unroll
                    for (int bj = 0; bj < 2; ++bj) *(u32x4*)(rowp + bj * 128) = pack8(gelu4(acc[ai][bj][m][0]), gelu4(acc[ai][bj][m][1])); }
        } else if (pn == 5) {
#pragma unroll
            for (int ai = 0; ai < 2; ++ai)
#pragma unroll
                for (int m = 0; m < 4; ++m) { const int row = row0 + ai * 128 + m * 16; bf16_t* rowp = V + (size_t)row * 256 + cw; float ss = 0.f;
#pragma unroll
                    for (int bj = 0; bj < 2; ++bj) { const f32x4 v0 = gelu4(acc[ai][bj][m][0]), v1 = gelu4(acc[ai][bj][m][1]); ss += sumsq4(v0) + sumsq4(v1); *(u32x4*)(rowp + bj * 128) = pack8(v0, v1); }
                    ss += shflx(ss, 16, fq * 16 + fr); ss += shflx(ss, 32, fq * 16 + fr);
                    if (fq == 0) PV[(size_t)row * 4 + wc] = ss; }
        } else {
#pragma unroll
            for (int ai = 0; ai < 2; ++ai)
#pragma unroll
                for (int m = 0; m < 4; ++m) { const int row = row0 + ai * 128 + m * 16;
                    const f32x4 v0 = acc[ai][0][m][0], v1 = acc[ai][0][m][1]; float ss = sumsq4(v0) + sumsq4(v1);
                    *(u32x4*)(CKV + (size_t)row * 128 + cw) = pack8(v0, v1);
                    ss += shflx(ss, 16, fq * 16 + fr); ss += shflx(ss, 32, fq * 16 + fr);
                    if (fq == 0) PKV[(size_t)row * 4 + wc] = ss;
                    if (wc == 0) {
                        const f32x4 a = acc[ai][1][m][0], b = acc[ai][1][m][1];
                        const f32x4* rp = (const f32x4*)(rope + ((size_t)(row & (SEQ - 1)) * 16 + 4 * fq) * 2);
                        const f32x4 c0 = rp[0], c1 = rp[1];
                        f32x4 ra, rb;
                        ra[0] = a[0] * c0[0] - a[1] * c0[1]; ra[1] = a[1] * c0[0] + a[0] * c0[1];
                        ra[2] = a[2] * c0[2] - a[3] * c0[3]; ra[3] = a[3] * c0[2] + a[2] * c0[3];
                        rb[0] = b[0] * c1[0] - b[1] * c1[1]; rb[1] = b[1] * c1[0] + b[0] * c1[1];
                        rb[2] = b[2] * c1[2] - b[3] * c1[3]; rb[3] = b[3] * c1[2] + b[2] * c1[3];
                        *(u32x4*)(KR + (size_t)row * 32 + 8 * fq) = pack8(ra, rb);
                    } }
        }
    }
};
struct EpiUq {
    static constexpr bool PERM = true, AFTER_DRAIN = false;
    bf16_t* Q; const float* PQ; const float* rope;
    __device__ __forceinline__ void operator()(const f32x4 (&acc)[2][2][4][2], const Unit& u, int wr, int wc, int fr, int fq) const {
        const int row0 = u.pm * 256 + wr * 64 + fr, col0 = u.pn * 256 + wc * 32 + 8 * fq;
#pragma unroll
        for (int ai = 0; ai < 2; ++ai)
#pragma unroll
            for (int m = 0; m < 4; ++m) { const int row = row0 + ai * 128 + m * 16;
                const f32x4 p = *(const f32x4*)(PQ + (size_t)row * 4);
                const float sc = QSCALE / sqrtf(((p[0] + p[1]) + (p[2] + p[3])) * (1.0f / 256.0f) + EPS);
#pragma unroll
                for (int bj = 0; bj < 2; ++bj) { const int c = col0 + bj * 128, w = c % 96;
                    f32x4 a = acc[ai][bj][m][0] * sc, b = acc[ai][bj][m][1] * sc;
                    if (w >= 64) {
                        const f32x4* rp = (const f32x4*)(rope + ((size_t)(row & (SEQ - 1)) * 16 + ((w - 64) >> 1)) * 2);
                        const f32x4 c0 = rp[0], c1 = rp[1]; f32x4 ra, rb;
                        ra[0] = a[0] * c0[0] - a[1] * c0[1]; ra[1] = a[1] * c0[0] + a[0] * c0[1];
                        ra[2] = a[2] * c0[2] - a[3] * c0[3]; ra[3] = a[3] * c0[2] + a[2] * c0[3];
                        rb[0] = b[0] * c1[0] - b[1] * c1[1]; rb[1] = b[1] * c1[0] + b[0] * c1[1];
                        rb[2] = b[2] * c1[2] - b[3] * c1[3]; rb[3] = b[3] * c1[2] + b[2] * c1[3];
                        a = ra; b = rb;
                    }
                    *(u32x4*)(Q + (size_t)row * NQ + c) = pack8(a, b); } }
    }
};
struct EpiUkv {
    static constexpr bool PERM = true, AFTER_DRAIN = false;
    bf16_t* KV; const float* PKV;
    __device__ __forceinline__ void operator()(const f32x4 (&acc)[2][2][4][2], const Unit& u, int wr, int wc, int fr, int fq) const {
        const int row0 = u.pm * 256 + wr * 64 + fr, col0 = u.pn * 256 + wc * 32 + 8 * fq;
#pragma unroll
        for (int ai = 0; ai < 2; ++ai)
#pragma unroll
            for (int m = 0; m < 4; ++m) { const int row = row0 + ai * 128 + m * 16;
                const f32x4 p = *(const f32x4*)(PKV + (size_t)row * 4);
                const float sc = 1.0f / sqrtf(((p[0] + p[1]) + (p[2] + p[3])) * (1.0f / 128.0f) + EPS);
#pragma unroll
                for (int bj = 0; bj < 2; ++bj) *(u32x4*)(KV + (size_t)row * NKV + col0 + bj * 128) = pack8(acc[ai][bj][m][0] * sc, acc[ai][bj][m][1] * sc); }
    }
};

struct MapId   { __device__ __forceinline__ int operator()(int n) const { return n; } };
struct MapGU   { __device__ __forceinline__ int operator()(int n) const { const int pn = n >> 8, w = n & 255; return w < 128 ? 128 * pn + w : DFF + 128 * pn + (w - 128); } };
struct MapIn   { __device__ __forceinline__ int operator()(int n) const {
    if (n < 1024) return n;
    if (n < 1280) return 1184 + (n - 1024);
    if (n < 1536) return 1440 + (n - 1280);
    if (n < 1664) return 1024 + (n - 1536);
    if (n < 1696) { const int j = n - 1664; return 1152 + (j >> 1) + 16 * (j & 1); }
    return -1; } };
struct MapUq   { __device__ __forceinline__ int operator()(int n) const { const int h = n / 96, w = n % 96; if (w < 64) return n; const int j = w - 64; return h * 96 + 64 + (j >> 1) + 16 * (j & 1); } };

template <class Map>
__device__ __forceinline__ void transpose_item(const float* __restrict__ W, int K, int Nsrc, bf16_t* __restrict__ WT, int Ndst, const float* __restrict__ gk, LAS float* scr, int item, int lane, Map map) {
    const int nblk = Ndst / 32, kb = item / nblk, nb = item % nblk, k0 = 64 * kb, n0 = 32 * nb;
    const int n4 = 4 * (lane & 7), ko = lane >> 3;
    const int s0 = map(n0 + n4), s1 = map(n0 + n4 + 1), s2 = map(n0 + n4 + 2), s3 = map(n0 + n4 + 3);
    const bool contig = (s0 >= 0) && (s1 == s0 + 1) && (s2 == s0 + 2) && (s3 == s0 + 3) && ((s0 & 3) == 0);
#pragma unroll
    for (int i = 0; i < 8; ++i) { const int kk = 8 * i + ko; f32x4 v = {0.f, 0.f, 0.f, 0.f};
        const float* wr = W + (size_t)(k0 + kk) * Nsrc;
        if (contig) v = *(const f32x4*)(wr + s0);
        else { if (s0 >= 0) v[0] = wr[s0]; if (s1 >= 0) v[1] = wr[s1]; if (s2 >= 0) v[2] = wr[s2]; if (s3 >= 0) v[3] = wr[s3]; }
        if (gk) v = v * gk[k0 + kk];
        LAS float* d = scr + kk * 33 + n4; d[0] = v[0]; d[1] = v[1]; d[2] = v[2]; d[3] = v[3]; }
    asm volatile("s_waitcnt lgkmcnt(0)" ::: "memory");
    const int c = lane & 7;
#pragma unroll
    for (int j = 0; j < 4; ++j) { const int n = (lane >> 3) + 8 * j; const LAS float* s = scr + (8 * c) * 33 + n;
        u32x4 o; o.x = cvtpk(s[0 * 33], s[1 * 33]); o.y = cvtpk(s[2 * 33], s[3 * 33]); o.z = cvtpk(s[4 * 33], s[5 * 33]); o.w = cvtpk(s[6 * 33], s[7 * 33]);
        *(u32x4*)(WT + (size_t)(n0 + n) * K + k0 + 8 * c) = o; }
    asm volatile("s_waitcnt lgkmcnt(0)" ::: "memory");
}

struct Args { const float* in[22]; float* out; unsigned char* ws; int ph_lo, ph_hi; };

__device__ __forceinline__ bf16_t* wptr(unsigned char* ws, int layer, size_t off) { return (bf16_t*)(ws + WS_W + (size_t)layer * WS_WL + off); }
constexpr size_t OFF_GU1 = 0, OFF_GU2 = 11 * MiB, OFF_DN1 = 22 * MiB, OFF_DN2 = 28 * MiB, OFF_IN = 34 * MiB, OFF_OUT = 38 * MiB,
                 OFF_UQ = 40 * MiB, OFF_UKV = 40 * MiB + 512 * 1024, OFF_GWS = 41 * MiB;

__device__ __forceinline__ void rope_table(float* rope, int gtid, int gthreads) {
    for (int idx = gtid; idx < SEQ * 16; idx += gthreads) {
        const int pos = idx >> 4, i = idx & 15;
        const float inv = 1.0f / exp2f((float)i * 0.8304820237218406f);
        const float ang = (float)pos * inv;
        const double rev = (double)ang * 0.15915494309189535;
        const float fr = (float)(rev - __builtin_rint(rev));
        rope[2 * idx] = __builtin_amdgcn_cosf(fr); rope[2 * idx + 1] = __builtin_amdgcn_sinf(fr);
    }
}
__device__ __forceinline__ void prologue_weights(const Args& a, unsigned char* ws_, LAS unsigned char* lds, int gw, int NGW, int wave, int lane) {
    LAS float* scr = (LAS float*)(lds + wave * 16384);
    constexpr int I_GU = 16 * (NGU / 32), I_DN = (DFF / 64) * 32, I_IN = 16 * (NIN_P / 32), I_UQ = 4 * (NQ / 32), I_UKV = 2 * 32, I_OUT = 16 * 32;
    constexpr int PER_LAYER = 2 * I_GU + 2 * I_DN + I_IN + I_UQ + I_UKV + I_OUT;
    for (int it = gw; it < 2 * PER_LAYER; it += NGW) {
        const int l = it / PER_LAYER; int r = it % PER_LAYER;
        if (r < I_GU) { transpose_item(a.in[2] + (size_t)l * DM * NGU, DM, NGU, wptr(ws_, l, OFF_GU1), NGU, a.in[1] + l * DM, scr, r, lane, MapGU()); continue; } r -= I_GU;
        if (r < I_GU) { transpose_item(a.in[19] + (size_t)l * DM * NGU, DM, NGU, wptr(ws_, l, OFF_GU2), NGU, a.in[18] + l * DM, scr, r, lane, MapGU()); continue; } r -= I_GU;
        if (r < I_DN) { transpose_item(a.in[3] + (size_t)l * DFF * DM, DFF, DM, wptr(ws_, l, OFF_DN1), DM, nullptr, scr, r, lane, MapId()); continue; } r -= I_DN;
        if (r < I_DN) { transpose_item(a.in[20] + (size_t)l * DFF * DM, DFF, DM, wptr(ws_, l, OFF_DN2), DM, nullptr, scr, r, lane, MapId()); continue; } r -= I_DN;
        if (r < I_IN) { transpose_item(a.in[6] + (size_t)l * DM * 1696, DM, 1696, wptr(ws_, l, OFF_IN), NIN_P, a.in[5] + l * DM, scr, r, lane, MapIn()); continue; } r -= I_IN;
        if (r < I_UQ) { transpose_item(a.in[10] + (size_t)l * 256 * NQ, 256, NQ, wptr(ws_, l, OFF_UQ), NQ, a.in[9] + l * 256, scr, r, lane, MapUq()); continue; } r -= I_UQ;
        if (r < I_UKV) { transpose_item(a.in[12] + (size_t)l * 128 * NKV, 128, NKV, wptr(ws_, l, OFF_UKV), NKV, a.in[11] + l * 128, scr, r, lane, MapId()); continue; } r -= I_UKV;
        transpose_item(a.in[16] + (size_t)l * DM * DM, DM, DM, wptr(ws_, l, OFF_OUT), DM, nullptr, scr, r, lane, MapId());
    }
    for (int idx = (gw * 64 + lane); idx < 2 * 4 * 128 * 128 / 4; idx += NGW * 64) {
        const int l = idx / (4 * 128 * 128 / 4), e = idx % (4 * 128 * 128 / 4);
        const f32x4 v = *(const f32x4*)(a.in[14] + (size_t)l * 65536 + 4 * e);
        u32x2 o; o.x = cvtpk(v[0], v[1]); o.y = cvtpk(v[2], v[3]);
        *(u32x2*)(wptr(ws_, l, OFF_GWS) + 4 * e) = o;
    }
}

constexpr int RP = 4;
__device__ __forceinline__ void wave_sum4(float (&s)[RP], int lane) {
#pragma unroll
    for (int o = 1; o < 64; o <<= 1) {
        float t[RP];
#pragma unroll
        for (int k = 0; k < RP; ++k) t[k] = shflx(s[k], o, lane);
#pragma unroll
        for (int k = 0; k < RP; ++k) s[k] += t[k];
    }
}
__device__ __forceinline__ void bf8_to_f32(const u32x4 w, f32x4& a, f32x4& b) { a = (f32x4){bflo(w.x), bfhi(w.x), bflo(w.y), bfhi(w.y)}; b = (f32x4){bflo(w.z), bfhi(w.z), bflo(w.w), bfhi(w.w)}; }
__device__ __forceinline__ void row_pass(const float* __restrict__ xf, const bf16_t* xb, const bf16_t* __restrict__ H, float coef, const float* __restrict__ gpost,
                                         float* __restrict__ xout, bf16_t* XB, float* SC, int gw, int NGW, int lane) {
    f32x4 gp[2][2];
#pragma unroll
    for (int j = 0; j < 2; ++j)
#pragma unroll
        for (int q = 0; q < 2; ++q) gp[j][q] = H ? *(const f32x4*)(gpost + 8 * lane + 512 * j + 4 * q) * coef : (f32x4){0.f, 0.f, 0.f, 0.f};
#pragma unroll 1
    for (int rit = gw * RP; rit < T_TOK; rit += NGW * RP) {
        int row0 = rit;
        if (NGW * RP == 8192) { const int j = rit >> 13, li = rit & 8191, pl = li >> 8; row0 = (32 * (4 * (j & 1) + (pl >> 3)) + 8 * (3 - (j >> 1)) + (pl & 7)) * 256 + (li & 255); }
        f32x4 v[RP][2][2]; u32x4 hw[RP][2];
        if (xf) {
#pragma unroll
            for (int k = 0; k < RP; ++k)
#pragma unroll
                for (int j = 0; j < 2; ++j)
#pragma unroll
                    for (int q = 0; q < 2; ++q) v[k][j][q] = __builtin_nontemporal_load((const f32x4*)(xf + (size_t)(row0 + k) * DM + 8 * lane + 512 * j + 4 * q));
        } else {
#pragma unroll
            for (int k = 0; k < RP; ++k) { const float sc = SC[row0 + k];
#pragma unroll
                for (int j = 0; j < 2; ++j) { const u32x4 w = __builtin_nontemporal_load((const u32x4*)(xb + (size_t)(row0 + k) * DM + 8 * lane + 512 * j)); bf8_to_f32(w, v[k][j][0], v[k][j][1]); v[k][j][0] = v[k][j][0] * sc; v[k][j][1] = v[k][j][1] * sc; } }
        }
        if (H) {
#pragma unroll
            for (int k = 0; k < RP; ++k)
#pragma unroll
                for (int j = 0; j < 2; ++j) hw[k][j] = __builtin_nontemporal_load((const u32x4*)(H + (size_t)(row0 + k) * DM + 8 * lane + 512 * j));
            float ss[RP];
#pragma unroll
            for (int k = 0; k < RP; ++k) { ss[k] = 0.f;
#pragma unroll
                for (int j = 0; j < 2; ++j) { f32x4 h0, h1; bf8_to_f32(hw[k][j], h0, h1); ss[k] += sumsq4(h0) + sumsq4(h1); } }
            wave_sum4(ss, lane);
#pragma unroll
            for (int k = 0; k < RP; ++k) { const float rstd = 1.0f / sqrtf(ss[k] * (1.0f / DM) + EPS);
#pragma unroll
                for (int j = 0; j < 2; ++j) { f32x4 h0, h1; bf8_to_f32(hw[k][j], h0, h1); v[k][j][0] = v[k][j][0] + h0 * rstd * gp[j][0]; v[k][j][1] = v[k][j][1] + h1 * rstd * gp[j][1]; } }
        }
        if (xout) {
#pragma unroll
            for (int k = 0; k < RP; ++k)
#pragma unroll
                for (int j = 0; j < 2; ++j)
#pragma unroll
                    for (int q = 0; q < 2; ++q) __builtin_nontemporal_store(v[k][j][q], (f32x4*)(xout + (size_t)(row0 + k) * DM + 8 * lane + 512 * j + 4 * q));
        }
        if (XB) {
            float ss[RP];
#pragma unroll
            for (int k = 0; k < RP; ++k) { ss[k] = 0.f;
#pragma unroll
                for (int j = 0; j < 2; ++j) ss[k] += sumsq4(v[k][j][0]) + sumsq4(v[k][j][1]); }
            wave_sum4(ss, lane);
#pragma unroll
            for (int k = 0; k < RP; ++k) { const float ms = ss[k] * (1.0f / DM) + EPS; const float rstd = 1.0f / sqrtf(ms);
#pragma unroll
                for (int j = 0; j < 2; ++j) __builtin_nontemporal_store(pack8(v[k][j][0] * rstd, v[k][j][1] * rstd), (u32x4*)(XB + (size_t)(row0 + k) * DM + 8 * lane + 512 * j));
                if (lane == 0) SC[row0 + k] = sqrtf(ms); }
        }
    }
}

__device__ __forceinline__ void unpack8(const u32x4 w, float (&o)[8]) { o[0] = bflo(w.x); o[1] = bfhi(w.x); o[2] = bflo(w.y); o[3] = bfhi(w.y); o[4] = bflo(w.z); o[5] = bfhi(w.z); o[6] = bflo(w.w); o[7] = bfhi(w.w); }
__device__ __forceinline__ void conv_phase(const bf16_t* __restrict__ ZC, const float* __restrict__ cw, const float* __restrict__ cb, bf16_t* __restrict__ Y, int gtid, int gthreads) {
    for (int item = gtid; item < (T_TOK / 16) * 32; item += gthreads) {
        const int ch = item & 31, rb = item >> 5, t0 = rb * 16, c0 = ch * 8;
        float w0[8], w1[8], w2[8], bb[8];
#pragma unroll
        for (int e = 0; e < 8; ++e) { w0[e] = cw[c0 + e]; w1[e] = cw[256 + c0 + e]; w2[e] = cw[512 + c0 + e]; bb[e] = cb[c0 + e]; }
        float zp[8], zc[8], zn[8];
        {
            if ((t0 & (SEQ - 1)) != 0) { float x[8], g[8]; unpack8(*(const u32x4*)(ZC + (size_t)(t0 - 1) * 768 + c0), x); unpack8(*(const u32x4*)(ZC + (size_t)(t0 - 1) * 768 + 512 + c0), g);
#pragma unroll
                for (int e = 0; e < 8; ++e) zp[e] = x[e] * g[e]; }
            else {
#pragma unroll
                for (int e = 0; e < 8; ++e) zp[e] = 0.f; }
            float x[8], g[8]; unpack8(*(const u32x4*)(ZC + (size_t)t0 * 768 + c0), x); unpack8(*(const u32x4*)(ZC + (size_t)t0 * 768 + 512 + c0), g);
#pragma unroll
            for (int e = 0; e < 8; ++e) zc[e] = x[e] * g[e];
        }
        for (int i = 0; i < 16; ++i) {
            const int t = t0 + i;
            if (((t + 1) & (SEQ - 1)) != 0) { float x[8], g[8]; unpack8(*(const u32x4*)(ZC + (size_t)(t + 1) * 768 + c0), x); unpack8(*(const u32x4*)(ZC + (size_t)(t + 1) * 768 + 512 + c0), g);
#pragma unroll
                for (int e = 0; e < 8; ++e) zn[e] = x[e] * g[e]; }
            else {
#pragma unroll
                for (int e = 0; e < 8; ++e) zn[e] = 0.f; }
            float gbv[8]; unpack8(*(const u32x4*)(ZC + (size_t)t * 768 + 256 + c0), gbv);
            float o[8];
#pragma unroll
            for (int e = 0; e < 8; ++e) o[e] = gbv[e] * (w0[e] * zp[e] + w1[e] * zc[e] + w2[e] * zn[e] + bb[e]);
            u32x4 w; w.x = cvtpk(o[0], o[1]); w.y = cvtpk(o[2], o[3]); w.z = cvtpk(o[4], o[5]); w.w = cvtpk(o[6], o[7]);
            *(u32x4*)(Y + (size_t)t * DM + c0) = w;
#pragma unroll
            for (int e = 0; e < 8; ++e) { zp[e] = zc[e]; zc[e] = zn[e]; }
        }
    }
}

__device__ __forceinline__ int lane_id() { int l; asm volatile("v_mbcnt_lo_u32_b32 %0, -1, 0\n\tv_mbcnt_hi_u32_b32 %0, -1, %0" : "=v"(l)); return l; }
#define MFMA32(a, b, c) __builtin_amdgcn_mfma_f32_32x32x16_bf16((a), (b), (c), 0, 0, 0)
__device__ __forceinline__ int crow(int i, int h) { return (i & 3) + 8 * (i >> 2) + 4 * h; }
template <int S> __device__ __forceinline__ bf16x8 packstep(const f32x16& x) {
    u32x4 p; p.x = cvtpk(x[8 * S], x[8 * S + 1]); p.y = cvtpk(x[8 * S + 2], x[8 * S + 3]); p.z = cvtpk(x[8 * S + 4], x[8 * S + 5]); p.w = cvtpk(x[8 * S + 6], x[8 * S + 7]);
    return __builtin_bit_cast(bf16x8, p);
}
typedef short v4i16_t __attribute__((ext_vector_type(4)));
__device__ __forceinline__ s16x4 tr_read(LAS unsigned char* p) { return __builtin_bit_cast(s16x4, __builtin_amdgcn_ds_read_tr16_b64_v4i16((LAS v4i16_t*)p)); }

constexpr int GM_PITCH = 272;
__device__ __forceinline__ void gmlp_phase(LAS unsigned char* lds, const bf16_t* __restrict__ U, const bf16_t* __restrict__ V, const float* __restrict__ PV, const float* __restrict__ gng,
                                           const bf16_t* __restrict__ WS, const float* __restrict__ bias, bf16_t* __restrict__ Y, int gw, int NGW, int wave, int lane) {
    LAS unsigned char* vt = lds + wave * (64 * GM_PITCH);
    const int r = lane & 31, hh = lane >> 5;
    for (int unit = gw; unit < 2048; unit += NGW) {
        const int g = unit & 3, bc = unit >> 2; const size_t row0 = (size_t)bc * 128;
        {
            const int ch = lane & 7; float gn[8];
#pragma unroll
            for (int e = 0; e < 8; ++e) gn[e] = gng[g * 64 + ch * 8 + e];
#pragma unroll 4
            for (int it = 0; it < 16; ++it) {
                const int q = it * 8 + (lane >> 3);
                const f32x4 p = *(const f32x4*)(PV + (row0 + q) * 4);
                const float rstd = 1.0f / sqrtf(((p[0] + p[1]) + (p[2] + p[3])) * (1.0f / 256.0f) + EPS);
                float x[8]; unpack8(*(const u32x4*)(V + (row0 + q) * 256 + g * 64 + ch * 8), x);
#pragma unroll
                for (int e = 0; e < 8; ++e) *(LAS unsigned short*)(vt + (ch * 8 + e) * GM_PITCH + q * 2) = f2bf(x[e] * rstd * gn[e]);
            }
        }
        asm volatile("s_waitcnt lgkmcnt(0)" ::: "memory");
        bf16x8 bfr[2][8];
#pragma unroll
        for (int dt = 0; dt < 2; ++dt)
#pragma unroll
            for (int ks = 0; ks < 8; ++ks) bfr[dt][ks] = *(LAS bf16x8*)(vt + (32 * dt + r) * GM_PITCH + (16 * ks + 8 * hh) * 2);
#pragma unroll 1
        for (int pt = 0; pt < 4; ++pt) {
            f32x16 o0 = {}, o1 = {};
            const bf16_t* wp = WS + ((size_t)(g * 128 + 32 * pt + r)) * 128 + 8 * hh;
#pragma unroll
            for (int ks = 0; ks < 8; ++ks) { const bf16x8 af = *(const bf16x8*)(wp + 16 * ks); o0 = MFMA32(bfr[0][ks], af, o0); o1 = MFMA32(bfr[1][ks], af, o1); }
            { const int pp = 32 * pt + r; const float bs = bias[g * 128 + pp];
              const bf16_t* up = U + (row0 + pp) * 256 + g * 64 + 4 * hh; bf16_t* yp = Y + (row0 + pp) * DM + 768 + g * 64 + 4 * hh;
#pragma unroll
              for (int q4 = 0; q4 < 4; ++q4) {
                  const u32x2 u0 = *(const u32x2*)(up + 8 * q4), u1 = *(const u32x2*)(up + 32 + 8 * q4);
                  u32x2 w0, w1;
                  w0.x = cvtpk(bflo(u0.x) * (o0[4 * q4] + bs), bfhi(u0.x) * (o0[4 * q4 + 1] + bs)); w0.y = cvtpk(bflo(u0.y) * (o0[4 * q4 + 2] + bs), bfhi(u0.y) * (o0[4 * q4 + 3] + bs));
                  w1.x = cvtpk(bflo(u1.x) * (o1[4 * q4] + bs), bfhi(u1.x) * (o1[4 * q4 + 1] + bs)); w1.y = cvtpk(bflo(u1.y) * (o1[4 * q4 + 2] + bs), bfhi(u1.y) * (o1[4 * q4 + 3] + bs));
                  *(u32x2*)(yp + 8 * q4) = w0; *(u32x2*)(yp + 32 + 8 * q4) = w1; } }
        }
        asm volatile("s_waitcnt lgkmcnt(0)" ::: "memory");
    }
}

__device__ __forceinline__ float xhalf_max(float m) { float a = m, b = m; asm volatile("v_nop\n\tv_nop\n\tv_permlane32_swap_b32 %0, %1" : "+v"(a), "+v"(b)); return fmaxf(a, b); }
__device__ __forceinline__ float xhalf_sum(float m) { float a = m, b = m; asm volatile("v_nop\n\tv_nop\n\tv_permlane32_swap_b32 %0, %1" : "+v"(a), "+v"(b)); return a + b; }
constexpr int AT_KP = 208, AT_VP = 144, AT_KB = 64 * AT_KP, AT_VB = 64 * AT_VP, AT_STAGE = AT_KB + AT_VB;
constexpr int AT_WSF = 2 * AT_STAGE, AT_QOFF = AT_WSF + 8 * 64 * 4, AT_QW = 64 * 192;
static_assert(AT_QOFF + 8 * AT_QW <= LDS_BYTES - 64, "attention LDS map");
#define FMAX2(a, b) __builtin_amdgcn_fmed3f((a), (b), __builtin_inff())
#define AT_SOFTMAX(s0, s1, m_run, l_run, oA, oB, wsfp) do { \
        float tmax = FMAX2(s0[0], s1[0]); \
        _Pragma("unroll") for (int i = 1; i < 16; ++i) tmax = FMAX2(tmax, FMAX2(s0[i], s1[i])); \
        tmax = xhalf_max(tmax); \
        if (__any(tmax > m_run + 8.0f)) { \
            const float m_new = fmaxf(m_run, tmax); const float f = __builtin_amdgcn_exp2f(m_run - m_new); m_run = m_new; l_run *= f; \
            if (hh == 0) (wsfp)[r] = f; \
            asm volatile("s_waitcnt lgkmcnt(0)" ::: "memory"); \
            _Pragma("unroll") for (int i = 0; i < 16; ++i) { const float fi = ((wsfp) + 4 * hh)[(i & 3) + 8 * (i >> 2)]; oA[i] *= fi; oB[i] *= fi; } \
        } \
        float ps = 0.f; \
        _Pragma("unroll") for (int i = 0; i < 16; ++i) { s0[i] = __builtin_amdgcn_exp2f(s0[i] - m_run); s1[i] = __builtin_amdgcn_exp2f(s1[i] - m_run); ps += s0[i] + s1[i]; } \
        l_run += ps; } while (0)

__device__ __forceinline__ void attn_phase(LAS unsigned char* lds, const bf16_t* __restrict__ Q, const bf16_t* __restrict__ KV, const bf16_t* __restrict__ KR, bf16_t* __restrict__ Y, int vcu, int G, const int tid) {
    const int lane = tid & 63, wid = __builtin_amdgcn_readfirstlane(tid >> 6), r = lane & 31, hh = lane >> 5;
    const int srow = tid >> 3, sch = tid & 7, rrow = (tid >> 2) & 63, rch = tid & 3;
    LAS float* wsf = (LAS float*)(lds + AT_WSF) + wid * 64;
    LAS unsigned char* qimg = lds + AT_QOFF + wid * AT_QW;
    const int i16 = lane & 15, tq = i16 >> 2, tp = i16 & 3, blk = (lane >> 4) & 1;
    const int voff = (4 * hh + tq) * AT_VP + blk * 32 + tp * 8;
    const int qsw = (r >> 2) & 3;
    for (int bh = vcu; bh < 256; bh += G) {
        const int b = bh >> 3, h = bh & 7; const size_t rowbase = (size_t)b * SEQ;
        const bf16_t* kvsrc = KV + (rowbase + srow) * NKV + h * 128 + sch * 8;
        const bf16_t* krsrc = KR + (rowbase + rrow) * 32 + rch * 8;
#pragma unroll 1
        for (int qb = 0; qb < 4; ++qb) {
            {
                const bf16_t* qsrc = Q + (rowbase + qb * 512 + wid * 64 + lane) * NQ + h * 96;
                const int key = (lane >> 2) & 3;
#pragma unroll
                for (int bq = 0; bq < 4; ++bq) { LAS unsigned char* dst = qimg + lane * 192 + ((bq ^ key) << 4);
#pragma unroll
                    for (int aq = 0; aq < 3; ++aq) *(LAS u32x4*)(dst + 64 * aq) = *(const u32x4*)(qsrc + (4 * aq + bq) * 8); }
            }
            u32x4 gk = *(const u32x4*)(kvsrc), gv = *(const u32x4*)(kvsrc + 64), gr = (u32x4){0u, 0u, 0u, 0u};
            if (tid < 256) gr = *(const u32x4*)(krsrc);
            float ma = -1e30f, la = 0.f, mb = -1e30f, lb = 0.f; f32x16 oa0 = {}, oa1 = {}, ob0 = {}, ob1 = {};
#pragma unroll 1
            for (int t = 0; t < SEQ / 64; ++t) {
                LAS unsigned char* kb = lds + (t & 1) * AT_STAGE; LAS unsigned char* vb = kb + AT_KB;
                *(LAS u32x4*)(kb + srow * AT_KP + sch * 16) = gk;
                *(LAS u32x4*)(vb + srow * AT_VP + sch * 16) = gv;
                if (tid < 256) *(LAS u32x4*)(kb + rrow * AT_KP + 128 + rch * 16) = gr;
                __syncthreads();
                if (t + 1 < SEQ / 64) { const size_t adv = (size_t)(t + 1) * 64;
                    gk = *(const u32x4*)(kvsrc + adv * NKV); gv = *(const u32x4*)(kvsrc + adv * NKV + 64);
                    if (tid < 256) gr = *(const u32x4*)(krsrc + adv * 32); }
                f32x16 sa0 = {}, sa1 = {}, sb0 = {}, sb1 = {};
#pragma unroll
                for (int ks = 0; ks < 6; ++ks) {
                    const bf16x8 k0 = *(LAS bf16x8*)(kb + r * AT_KP + ks * 32 + hh * 16);
                    const bf16x8 k1 = *(LAS bf16x8*)(kb + (32 + r) * AT_KP + ks * 32 + hh * 16);
                    const int qc = ((2 * ks + hh) ^ qsw) << 4;
                    const bf16x8 qa = *(LAS bf16x8*)(qimg + r * 192 + qc);
                    const bf16x8 qb2 = *(LAS bf16x8*)(qimg + (32 + r) * 192 + qc);
                    sa0 = MFMA32(k0, qa, sa0); sa1 = MFMA32(k1, qa, sa1);
                    sb0 = MFMA32(k0, qb2, sb0); sb1 = MFMA32(k1, qb2, sb1);
                }
                AT_SOFTMAX(sa0, sa1, ma, la, oa0, oa1, wsf);
                const bf16x8 pa00 = packstep<0>(sa0), pa01 = packstep<1>(sa0), pa10 = packstep<0>(sa1), pa11 = packstep<1>(sa1);
                AT_SOFTMAX(sb0, sb1, mb, lb, ob0, ob1, wsf + 32);
                const bf16x8 pb00 = packstep<0>(sb0), pb01 = packstep<1>(sb0), pb10 = packstep<0>(sb1), pb11 = packstep<1>(sb1);
#define PVSTEP(pa, pb, kv0) do { \
                    const s16x4 l0 = tr_read(vb + (kv0) * AT_VP + voff), h0 = tr_read(vb + ((kv0) + 8) * AT_VP + voff); \
                    const s16x4 l1 = tr_read(vb + (kv0) * AT_VP + voff + 64), h1 = tr_read(vb + ((kv0) + 8) * AT_VP + voff + 64); \
                    const bf16x8 v0 = __builtin_shufflevector(l0, h0, 0, 1, 2, 3, 4, 5, 6, 7), v1 = __builtin_shufflevector(l1, h1, 0, 1, 2, 3, 4, 5, 6, 7); \
                    oa0 = MFMA32(pa, v0, oa0); oa1 = MFMA32(pa, v1, oa1); ob0 = MFMA32(pb, v0, ob0); ob1 = MFMA32(pb, v1, ob1); } while (0)
                PVSTEP(pa00, pb00, 0); PVSTEP(pa01, pb01, 16); PVSTEP(pa10, pb10, 32); PVSTEP(pa11, pb11, 48);
#undef PVSTEP
            }
            const float lta = xhalf_sum(la), ltb = xhalf_sum(lb);
            if (hh == 0) { wsf[r] = 1.0f / lta; wsf[32 + r] = 1.0f / ltb; }
            asm volatile("s_waitcnt lgkmcnt(0)" ::: "memory");
            bf16_t* yp = Y + (rowbase + qb * 512 + wid * 64 + 4 * hh) * DM + 256 + h * 64 + r;
            asm volatile("" : "+v"(yp));
            LAS float* wsfh = wsf + 4 * hh;
#pragma unroll
            for (int i = 0; i < 16; ++i) { const int q = (i & 3) + 8 * (i >> 2); const float fa = wsfh[q], fb = wsfh[32 + q];
                yp[(size_t)q * DM] = f2bf(oa0[i] * fa); yp[(size_t)q * DM + 32] = f2bf(oa1[i] * fa);
                yp[(size_t)(32 + q) * DM] = f2bf(ob0[i] * fb); yp[(size_t)(32 + q) * DM + 32] = f2bf(ob1[i] * fb); }
            __syncthreads();
        }
    }
}

#define XB_TMO      128
#define XB_XCNT(j)  (256  + 64 * (j))
#define XB_XSUB(j)  (1280 + 64 * (j))
#define XB_XGEN(j)  (2304 + 64 * (j))
#define XB_TOP      3328
#define XB_TOPGEN   3392
#define XCD_BAR_WORDS 3456
#define XB_SPIN_CAP (1u << 18)

__device__ __forceinline__ unsigned xb_ld(unsigned* p)              { return __hip_atomic_load(p, __ATOMIC_RELAXED, __HIP_MEMORY_SCOPE_AGENT); }
__device__ __forceinline__ unsigned xb_add(unsigned* p, unsigned v) { return __hip_atomic_fetch_add(p, v, __ATOMIC_RELAXED, __HIP_MEMORY_SCOPE_AGENT); }
__device__ __forceinline__ unsigned xb_xcc_id() { return (unsigned)__builtin_amdgcn_s_getreg((3 << 11) | 20) & 0xFu; }
#define XB_SPIN(cond, bar) do { unsigned _sp = 0; while (cond) { __builtin_amdgcn_s_sleep(1); \
    if ((++_sp & 255u) == 0u) { if (xb_ld(&(bar)[XB_TMO])) break; if (_sp > XB_SPIN_CAP) { atomicAdd(&(bar)[XB_TMO], 1u); break; } } } } while (0)

struct XcdBarrier {
    unsigned* bar; unsigned x;
    volatile LAS unsigned* st;
};

__device__ __forceinline__ XcdBarrier xcd_barrier_post(unsigned* bar, volatile LAS unsigned* st) {
    XcdBarrier b; b.bar = bar; b.x = xb_xcc_id(); b.st = st;
    if (threadIdx.x == 0) (void)xb_add(&bar[XB_XCNT(b.x)], 1u);
    return b;
}
__device__ __forceinline__ void xcd_barrier_complete(unsigned* bar, unsigned x, unsigned& nloc, unsigned& nx) {
    const unsigned G = gridDim.x * gridDim.y * gridDim.z;
    unsigned sum, cnt, mine, sp = 0u;
    for (;;) {
        sum = 0u; cnt = 0u; mine = 0u;
#pragma unroll
        for (unsigned j = 0; j < 16; ++j) { const unsigned c = xb_ld(&bar[XB_XCNT(j)]); sum += c; cnt += (c > 0u) ? 1u : 0u; mine = (j == x) ? c : mine; }
        if (sum == G) break;
        __builtin_amdgcn_s_sleep(1);
        if ((++sp & 255u) == 0u) { if (xb_ld(&bar[XB_TMO])) break; if (sp > XB_SPIN_CAP) { atomicAdd(&bar[XB_TMO], 1u); break; } }
    }
    nloc = mine > 0u ? mine : 1u; nx = cnt > 0u ? cnt : 1u;
}

__device__ __forceinline__ void xcd_barrier(const XcdBarrier& b) {
    asm volatile("s_waitcnt vmcnt(0)" ::: "memory");
    __syncthreads();
    if (threadIdx.x == 0) {
        unsigned* bar = b.bar;
        __builtin_amdgcn_s_waitcnt(0);
        unsigned nloc = b.st[0], nx = b.st[1];
        if (nloc == 0u) { xcd_barrier_complete(bar, b.x, nloc, nx); b.st[0] = nloc; b.st[1] = nx; }
        const unsigned old = xb_add(&bar[XB_XSUB(b.x)], 1u);
        const unsigned gen = old / nloc;
        if (old + 1u == (gen + 1u) * nloc) {
            __builtin_amdgcn_fence(__ATOMIC_RELEASE, "agent");
            asm volatile("s_waitcnt vmcnt(0)" ::: "memory");
            const unsigned og = xb_add(&bar[XB_TOP], 1u);
            const unsigned tg = og / nx;
            if (og + 1u == (tg + 1u) * nx) xb_add(&bar[XB_TOPGEN], 1u);
            else XB_SPIN(xb_ld(&bar[XB_TOPGEN]) == tg, bar);
            __builtin_amdgcn_fence(__ATOMIC_ACQUIRE, "agent");
            xb_add(&bar[XB_XGEN(b.x)], 1u);
            asm volatile("s_waitcnt vmcnt(0)" ::: "memory");
        } else {
            XB_SPIN(xb_ld(&bar[XB_XGEN(b.x)]) == gen, bar);
            __builtin_amdgcn_fence(__ATOMIC_ACQUIRE, "agent");
            asm volatile("s_waitcnt vmcnt(0)" ::: "memory");
        }
    }
    __syncthreads();
}


#ifndef REP_CONV
#define REP_CONV 1
#endif
#ifndef REP_GMLP
#define REP_GMLP 1
#endif
#ifndef REP_PRO
#define REP_PRO 1
#endif
#ifndef REP_RP
#define REP_RP 1
#endif
#ifndef REP_GU
#define REP_GU 1
#endif
#ifndef REP_DN
#define REP_DN 1
#endif
#ifndef REP_WIN
#define REP_WIN 1
#endif
#ifndef REP_MIX2
#define REP_MIX2 1
#endif
#define GEMM_CALL(EpiT, E, Aptr, Bptr, Mv, Nv, Kv) do { pg8::Gemm g_{(Aptr), (Bptr), (Mv), (Nv), (Kv)}; pg8::StaticOrder S_; S_.init((Mv), (Nv), G, (int)blockIdx.x); \
        int l_o_ = lane_id(); asm volatile("" : "+v"(l_o_)); pg8::gemm_phase<EpiT, pg8::StaticOrder, true, true>(lds, g_, S_, (E), wave * 64 + l_o_); __syncthreads(); } while (0)

__global__ void __launch_bounds__(NTHR, 2) mk_fwd(Args a) {
    extern __shared__ __attribute__((aligned(16))) unsigned char lds_raw[];
    LAS unsigned char* lds = (LAS unsigned char*)lds_raw;
    cg::grid_group grid = cg::this_grid();
    const int wave = __builtin_amdgcn_readfirstlane((int)threadIdx.x >> 6);
    const int G = gridDim.x, bx = blockIdx.x, vcu = (G % 8 == 0) ? (bx % 8) * (G / 8) + bx / 8 : bx;
    const int gw = vcu * NWAVES + wave, NGW = G * NWAVES, gthreads = G * NTHR;
    unsigned char* const ws_k = a.ws;
#define rope ((float*)(ws + WS_ROPE))
#define PQ ((float*)(ws + WS_PQ))
#define PKV ((float*)(ws + WS_PKV))
#define PV ((float*)(ws + WS_PV))
#define RSv ((float*)(ws + WS_RS))
#define XN ((bf16_t*)(ws + WS_XN))
#define ACT ((bf16_t*)(ws + WS_ACT))
#define ZC ((bf16_t*)(ws + WS_ZC))
#define CQ ((bf16_t*)(ws + WS_CQ))
#define Ub ((bf16_t*)(ws + WS_U))
#define Vb ((bf16_t*)(ws + WS_V))
#define CKV ((bf16_t*)(ws + WS_CKV))
#define KR ((bf16_t*)(ws + WS_KR))
#define Qb ((bf16_t*)(ws + WS_Q))
#define KVb ((bf16_t*)(ws + WS_KV))
#define Yb ((bf16_t*)(ws + WS_Y))
#define Hb ((bf16_t*)(ws + WS_H))
    float* X = a.out;
    volatile LAS unsigned* misc = (volatile LAS unsigned*)(lds + LDS_BYTES - 64);
    if (threadIdx.x < 2) misc[threadIdx.x] = 0u;
    if (bx == 0) { for (int i = threadIdx.x; i < XCD_BAR_WORDS; i += NTHR) ((unsigned*)(a.ws + 65536))[i] = 0u; }
    XcdBarrier xbar; xbar.bar = (unsigned*)(a.ws + 65536); xbar.x = 0; xbar.st = misc;
    int ph = 0;
    const int lo = a.ph_lo, hi = a.ph_hi;
#define RUN (ph >= lo && ph < hi)
#define OPAQUE_IDS unsigned long long wsv_ = (unsigned long long)ws_k; asm volatile("" : "+s"(wsv_)); unsigned char* ws = (unsigned char*)(__attribute__((address_space(1))) unsigned char*)wsv_; int lane_o_ = lane_id(); asm volatile("" : "+v"(lane_o_)); const int tid = wave * 64 + lane_o_; const int lane = tid & 63, gtid = bx * NTHR + tid; (void)lane; (void)gtid;
#define SEAM do { if (ph >= lo && ph + 1 < hi) { if (ph == 0) { grid.sync(); xbar = xcd_barrier_post((unsigned*)(a.ws + 65536), misc); } else xcd_barrier(xbar); } ++ph; } while (0)

    if (RUN) { OPAQUE_IDS
#ifndef NO_PRO
        _Pragma("unroll 1") for (int rr_ = 0; rr_ < REP_PRO; ++rr_) prologue_weights(a, ws, lds, gw, NGW, wave, lane);
#endif
        rope_table(rope, gtid, gthreads);
        row_pass(a.in[0], nullptr, nullptr, 0.f, nullptr, nullptr, XN, RSv, gw, NGW, lane);
    }
    SEAM;

#pragma unroll 1
    for (int sb = 0; sb < 6; ++sb) {
        const int l = sb / 3, kind = sb % 3;
        if (kind != 1) {
            #ifndef NO_GU
            _Pragma("unroll 1") for (int rep_ = 0; rep_ < REP_GU; ++rep_)
            if (RUN) { OPAQUE_IDS EpiSwiGLU E{ACT, RSv}; GEMM_CALL(EpiSwiGLU, E, XN, wptr(ws, l, kind == 0 ? OFF_GU1 : OFF_GU2), T_TOK, NGU, DM); }
#endif
            SEAM;
            #ifndef NO_DN
            _Pragma("unroll 1") for (int rep_ = 0; rep_ < REP_DN; ++rep_)
#ifdef PROBE_SPLIT_DN
            _Pragma("unroll 1") for (int half_ = 0; half_ < 2; ++half_) { OPAQUE_IDS EpiPlain E{Hb, DM};
                { pg8::Gemm g_{ACT, wptr(ws, l, kind == 0 ? OFF_DN1 : OFF_DN2), T_TOK, DM, DFF}; pg8::StaticOrder S_; S_.init(T_TOK, DM, G, (int)blockIdx.x); S_.i0 = 2 * half_; S_.iend = 2 * half_ + 2;
                  int l_o_ = lane_id(); asm volatile("" : "+v"(l_o_)); pg8::gemm_phase<EpiPlain, pg8::StaticOrder, true, true>(lds, g_, S_, E, wave * 64 + l_o_); __syncthreads(); }
                if (half_ == 0) xcd_barrier(xbar); }
#else
            if (RUN) { OPAQUE_IDS EpiPlain E{Hb, DM}; GEMM_CALL(EpiPlain, E, ACT, wptr(ws, l, kind == 0 ? OFF_DN1 : OFF_DN2), T_TOK, DM, DFF); }
#endif
#endif
            SEAM;
            if (RUN) { OPAQUE_IDS
                const float* gpost = a.in[kind == 0 ? 4 : 21] + l * DM;
                if (sb == 0) { _Pragma("unroll 1") for (int rr_ = 0; rr_ < REP_RP; ++rr_) row_pass(a.in[0], nullptr, Hb, 0.5f, gpost, nullptr, XN, RSv, gw, NGW, lane); }
                else if (sb == 5) row_pass(nullptr, XN, Hb, 0.5f, gpost, X, nullptr, RSv, gw, NGW, lane);
                else row_pass(nullptr, XN, Hb, 0.5f, gpost, nullptr, XN, RSv, gw, NGW, lane);
            }
            SEAM;
        } else {
            #ifndef NO_WIN
            _Pragma("unroll 1") for (int rep_ = 0; rep_ < REP_WIN; ++rep_)
            if (RUN) { OPAQUE_IDS EpiWin E{ZC, CQ, Ub, Vb, CKV, KR, PQ, PV, PKV, rope, RSv}; GEMM_CALL(EpiWin, E, XN, wptr(ws, l, OFF_IN), T_TOK, NIN_P, DM); }
#endif
            SEAM;
            _Pragma("unroll 1") for (int rep_ = 0; rep_ < REP_MIX2; ++rep_)
            if (RUN) { OPAQUE_IDS
#ifndef NO_UQ
                { EpiUq E{Qb, PQ, rope}; GEMM_CALL(EpiUq, E, CQ, wptr(ws, l, OFF_UQ), T_TOK, NQ, 256); }
#endif
#ifndef NO_UKV
                { EpiUkv E{KVb, PKV}; GEMM_CALL(EpiUkv, E, CKV, wptr(ws, l, OFF_UKV), T_TOK, NKV, 128); }
#endif
#ifndef NO_CONV
                _Pragma("unroll 1") for (int rc_ = 0; rc_ < REP_CONV; ++rc_) { OPAQUE_IDS conv_phase(ZC, a.in[7] + l * 768, a.in[8] + l * 256, Yb, gtid, gthreads); }
#endif
#ifndef NO_GMLP
                _Pragma("unroll 1") for (int rg_ = 0; rg_ < REP_GMLP; ++rg_) { OPAQUE_IDS gmlp_phase(lds, Ub, Vb, PV, a.in[13] + l * 256, wptr(ws, l, OFF_GWS), a.in[15] + l * 512, Yb, gw, NGW, wave, lane); }
#endif
            }
            SEAM;
#ifndef NO_ATTN
            if (RUN) { OPAQUE_IDS attn_phase(lds, Qb, KVb, KR, Yb, vcu, G, tid); }
#ifdef PROBE_DUP_ATTN
            if (RUN) { __syncthreads(); OPAQUE_IDS attn_phase(lds, Qb, KVb, KR, Yb, vcu, G, tid); }
#endif
#endif
            SEAM;
#ifndef NO_OUT
            _Pragma("unroll 1") for (int rep_ = 0; rep_ < REP_WIN; ++rep_)
            if (RUN) { OPAQUE_IDS EpiPlain E{Hb, DM}; GEMM_CALL(EpiPlain, E, Yb, wptr(ws, l, OFF_OUT), T_TOK, DM, DM); }
#endif
            SEAM;
            if (RUN) { OPAQUE_IDS row_pass(nullptr, XN, Hb, 1.0f, a.in[17] + l * DM, nullptr, XN, RSv, gw, NGW, lane); }
            SEAM;
        }
    }
}
constexpr int N_PHASES = 1 + 2 * (3 + 5 + 3);

#ifndef MK_SPLIT
#define MK_SPLIT 0
#endif
extern "C" void kernel_launch(void* const* d_in, const int* in_sizes, int n_in, void* d_out, int out_size, void* d_ws, size_t ws_size, hipStream_t stream) {
    static int grid = 0;
    if (grid == 0) {
        if (n_in != 22 || out_size != T_TOK * DM || ws_size < WS_END) { fprintf(stderr, "kernel_launch: unexpected shapes n_in %d out %d ws %zu\n", n_in, out_size, ws_size); grid = -1; return; }
        int dev = 0, cus = 0, per_cu = 0;
        (void)hipGetDevice(&dev); (void)hipDeviceGetAttribute(&cus, hipDeviceAttributeMultiprocessorCount, dev);
        if (hipFuncSetAttribute((const void*)mk_fwd, hipFuncAttributeMaxDynamicSharedMemorySize, LDS_BYTES) != hipSuccess) { fprintf(stderr, "kernel_launch: hipFuncSetAttribute failed\n"); grid = -1; return; }
        if (hipOccupancyMaxActiveBlocksPerMultiprocessor(&per_cu, (const void*)mk_fwd, NTHR, LDS_BYTES) != hipSuccess || per_cu < 1) { fprintf(stderr, "kernel_launch: occupancy query says %d\n", per_cu); per_cu = 1; }
        (void)hipGetLastError();
        grid = cus * per_cu;
        if (grid > cus) grid = cus;
    }
    if (grid < 0) return;
    Args a{};
    for (int i = 0; i < 22; ++i) a.in[i] = (const float*)d_in[i];
    a.out = (float*)d_out; a.ws = (unsigned char*)d_ws;
#if MK_SPLIT
    for (int p = 0; p < N_PHASES; ++p) { a.ph_lo = p; a.ph_hi = p + 1; hipLaunchKernelGGL(mk_fwd, dim3(grid), dim3(NTHR), LDS_BYTES, stream, a); }
#else
    a.ph_lo = 0; a.ph_hi = N_PHASES;
    void* args[] = {&a};
    hipError_t e = hipLaunchCooperativeKernel((const void*)mk_fwd, dim3(grid), dim3(NTHR), args, LDS_BYTES, stream);
    if (e != hipSuccess) fprintf(stderr, "cooperative launch failed: %s (grid %d)\n", hipGetErrorString(e), grid);
#endif
}
```

```cpp
#include <hip/hip_runtime.h>
#include <hip/hip_cooperative_groups.h>
#include <cstdio>
#include <cstdint>
namespace cg = cooperative_groups;
namespace pg8 {
#define PG8_LAS __attribute__((address_space(3)))
typedef unsigned short bf16_t;
typedef short bf16x8 __attribute__((ext_vector_type(8)));
typedef float f32x4 __attribute__((ext_vector_type(4)));
typedef unsigned u32x4 __attribute__((ext_vector_type(4)));
constexpr int BM = 256, BK = 64, HALF = 128, HTB = HALF * BK * 2  , STAGE_BYTES = 8 * HTB, NXCD = 8, WGM = 8;

__host__ __device__ __forceinline__ int lds_byte(int r, int c) { const int st = (r >> 4) * 2 + (c >> 5), rr = r & 15, cc = c & 31, ob = rr * 64 + cc * 2; return st * 1024 + (ob ^ (((ob >> 9) & 1) << 5)); }
__host__ __device__ __forceinline__ void stage_rc(int b, int& R, int& C) { const int st = b / 1024, sb = b % 1024, swz = sb ^ (((sb >> 9) & 1) << 5); R = (st >> 1) * 16 + swz / 64; C = (st & 1) * 32 + (swz % 64) / 2; }
__host__ __device__ __forceinline__ int perm32(int rho) { const int n = rho >> 4, i = rho & 15; return 8 * (i >> 2) + 4 * n + (i & 3); }

struct Unit { int pm, pn; };
struct Gemm { const bf16_t* A; const bf16_t* Bt; int M, N, K; };

struct StaticOrder {
    int nM, nN, nwg, G, c, i0, iend;
    __host__ __device__ void init(int M, int N, int G_, int c_) { nM = M / BM; nN = N / BM; nwg = nM * nN; G = G_; c = c_; i0 = 0; iend = 1 << 30; }
    __host__ __device__ bool next(int i, Unit& u) const {
        const long L = (long)(i + i0) * G + c; if (i + i0 >= iend || L >= nwg) return false;
        int wgid = (int)L; { const int q = nwg / NXCD, r = nwg % NXCD, xcd = wgid % NXCD, off = wgid / NXCD; wgid = (xcd < r ? xcd * (q + 1) : r * (q + 1) + (xcd - r) * q) + off; }
        const int nig = WGM * nN, gid = wgid / nig, fm = gid * WGM, gsz = (nM - fm) < WGM ? (nM - fm) : WGM;
        u.pm = fm + ((wgid % nig) % gsz); u.pn = (wgid % nig) / gsz; return true;
    }
    __device__ __forceinline__ void a_ready(const Unit&) const {}
    __device__ __forceinline__ void done(const Unit&) const {}
};

__device__ __forceinline__ unsigned cvt_pk_bf16(float lo, float hi) { unsigned r; asm volatile("v_cvt_pk_bf16_f32 %0, %1, %2" : "=v"(r) : "v"(lo), "v"(hi)); return r; }
typedef float f32x2 __attribute__((ext_vector_type(2)));
__device__ __forceinline__ f32x2 gelu_pk(f32x2 v) {
    const f32x2 av = __builtin_elementwise_abs(v), d = av * 0.2316418882f + 1.0f;
    f32x2 t; t.x = __builtin_amdgcn_rcpf(d.x); t.y = __builtin_amdgcn_rcpf(d.y);
    f32x2 q = t * 0.5307027145f + (-0.7265760135f); q = q * t + 0.7107068705f; q = q * t + (-0.142248368f); q = q * t + 0.127414796f; q = q * t;
    const f32x2 s = (v * v) * (-0.72134752044f);
    f32x2 e; e.x = __builtin_amdgcn_exp2f(s.x); e.y = __builtin_amdgcn_exp2f(s.y);
    const f32x2 m = v * (q * e), r = v - m;
    f32x2 o; o.x = v.x < 0.f ? m.x : r.x; o.y = v.y < 0.f ? m.y : r.y; return o;
}
template <class Epi, class Sched, bool ALIGN_EPI = false, bool SP2 = false>
__device__ __forceinline__ void gemm_phase(PG8_LAS unsigned char* lds, const Gemm g, const Sched& S, const Epi& E, const int tid_in) {
    const int tid = tid_in, wid = __builtin_amdgcn_readfirstlane(tid >> 6), lane = tid & 63, wr = wid >> 2, wc = wid & 3, fr = lane & 15, fq = lane >> 4;
    const int K = g.K, nt = K / BK;
    unsigned voffA[2], voffB[2];
#pragma unroll
    for (int i = 0; i < 2; ++i) { int R, C; stage_rc(tid * 16 + i * 8192, R, C); const int Rb = Epi::PERM ? ((R & ~31) + perm32(R & 31)) : R;
        voffA[i] = (unsigned)(R * K + C) * 2u; voffB[i] = (unsigned)(Rb * K + C) * 2u; }
    const size_t kstep = (size_t)(BK * 2);
    const size_t hstep = (size_t)HALF * K * 2;
    const size_t tstep = 2 * hstep;
    const unsigned ldsw = (unsigned)wid * 1024u;
    const int aoff = lds_byte(wr * 64 + fr, fq * 8), boff = lds_byte(wc * 32 + fr, fq * 8);
#define PG8_SA(b, h) (((b) * 2 + (h)) * HTB)
#define PG8_SB(b, h) ((4 + (b) * 2 + (h)) * HTB)
#define PG8_STAGE(bufoff, gbase, voff) do { _Pragma("unroll") for (int _i = 0; _i < 2; ++_i) \
        __builtin_amdgcn_global_load_lds((const unsigned*)((const char*)(gbase) + (voff)[_i]), (PG8_LAS unsigned*)(lds + (bufoff) + ldsw + _i * 8192), 16, 0, 0); } while (0)
#define PG8_LDA(dst, b, h) do { _Pragma("unroll") for (int m = 0; m < 4; ++m) _Pragma("unroll") for (int k = 0; k < 2; ++k) dst[m][k] = *(const PG8_LAS bf16x8*)(lds + PG8_SA(b, h) + aoff + m * 2048 + k * 1024); } while (0)
#define PG8_LDB(dst, b, h) do { _Pragma("unroll") for (int n = 0; n < 2; ++n) _Pragma("unroll") for (int k = 0; k < 2; ++k) dst[n][k] = *(const PG8_LAS bf16x8*)(lds + PG8_SB(b, h) + boff + n * 2048 + k * 1024); } while (0)
#define PG8_MMA(ai, bj, At, Bt) do { __builtin_amdgcn_s_setprio(1); _Pragma("unroll") for (int m = 0; m < 4; ++m) _Pragma("unroll") for (int n = 0; n < 2; ++n) _Pragma("unroll") for (int k = 0; k < 2; ++k) \
        acc[ai][bj][m][n] = __builtin_amdgcn_mfma_f32_16x16x32_bf16(Bt[n][k], At[m][k], acc[ai][bj][m][n], 0, 0, 0); __builtin_amdgcn_s_setprio(0); } while (0)
#define PG8_WAIT_V(n) asm volatile("s_waitcnt vmcnt(" #n ")" ::: "memory")
#define PG8_WAIT_L(n) asm volatile("s_waitcnt lgkmcnt(" #n ")" ::: "memory")
#define PG8_BAR __builtin_amdgcn_s_barrier()
#define PG8_SCHED __builtin_amdgcn_sched_barrier(0)
    Unit cur, nxt; int ui = 0;
    if (!S.next(0, cur)) return;
    f32x4 acc[2][2][4][2];
#pragma unroll
    for (int a = 0; a < 2; ++a)
#pragma unroll
        for (int b = 0; b < 2; ++b)
#pragma unroll
            for (int m = 0; m < 4; ++m)
#pragma unroll
                for (int n = 0; n < 2; ++n) acc[a][b][m][n] = (f32x4){0.f, 0.f, 0.f, 0.f};
    bf16x8 At[4][2], B0[2][2], B1[2][2];
    const char* cA = (const char*)g.A + (size_t)cur.pm * tstep; const char* cB = (const char*)g.Bt + (size_t)cur.pn * tstep;
    S.a_ready(cur);
    if constexpr (SP2) {
        PG8_STAGE(PG8_SB(0, 0), cB, voffB); PG8_STAGE(PG8_SB(0, 1), cB + hstep, voffB); PG8_STAGE(PG8_SA(0, 0), cA, voffA); PG8_STAGE(PG8_SA(0, 1), cA + hstep, voffA);
        if (wr == 1) PG8_BAR;
        PG8_WAIT_V(2); PG8_BAR;
        PG8_STAGE(PG8_SB(1, 0), cB + kstep, voffB); PG8_STAGE(PG8_SA(1, 0), cA + kstep, voffA); PG8_STAGE(PG8_SB(1, 1), cB + hstep + kstep, voffB);
        PG8_WAIT_V(6); PG8_BAR;
    } else {
        PG8_STAGE(PG8_SB(0, 0), cB, voffB); PG8_STAGE(PG8_SA(0, 0), cA, voffA); PG8_STAGE(PG8_SB(0, 1), cB + hstep, voffB); PG8_STAGE(PG8_SA(0, 1), cA + hstep, voffA);
        if (wr == 1) PG8_BAR;
        PG8_WAIT_V(4); PG8_BAR;
        PG8_STAGE(PG8_SB(1, 0), cB + kstep, voffB); PG8_STAGE(PG8_SA(1, 0), cA + kstep, voffA); PG8_STAGE(PG8_SB(1, 1), cB + hstep + kstep, voffB);
        PG8_WAIT_V(6); PG8_BAR;
    }
    for (;;) {
        const bool has_next = S.next(ui + 1, nxt);
        const char* nA = has_next ? (const char*)g.A + (size_t)nxt.pm * tstep : cA; const char* nB = has_next ? (const char*)g.Bt + (size_t)nxt.pn * tstep : cB;
        for (int t = 0; t < nt; t += 2) {
            const bool last = (t == nt - 2);
            const char* a1 = cA + (size_t)(t + 1) * kstep;
            const char* a2 = last ? nA : cA + (size_t)(t + 2) * kstep; const char* b2 = last ? nB : cB + (size_t)(t + 2) * kstep;
            const char* a3 = a2 + kstep; const char* b3 = b2 + kstep;
            if (last && has_next) S.a_ready(nxt);
            if constexpr (SP2) {
            PG8_LDB(B0, 0, 0); PG8_LDB(B1, 0, 1); PG8_SCHED; PG8_LDA(At, 0, 0); PG8_STAGE(PG8_SA(1, 1), a1 + hstep, voffA);
            PG8_WAIT_V(8); PG8_WAIT_L(0); PG8_BAR; PG8_MMA(0, 0, At, B0); PG8_MMA(0, 1, At, B1); PG8_BAR; PG8_SCHED;
            PG8_LDA(At, 0, 1); PG8_STAGE(PG8_SB(0, 0), b2, voffB); PG8_STAGE(PG8_SB(0, 1), b2 + hstep, voffB); PG8_STAGE(PG8_SA(0, 0), a2, voffA);
            PG8_WAIT_V(8); PG8_WAIT_L(0); PG8_BAR; PG8_MMA(1, 0, At, B0); PG8_MMA(1, 1, At, B1); PG8_BAR; PG8_SCHED;
            PG8_LDB(B0, 1, 0); PG8_LDB(B1, 1, 1); PG8_SCHED; PG8_LDA(At, 1, 0); PG8_STAGE(PG8_SA(0, 1), a2 + hstep, voffA);
            PG8_WAIT_V(8); PG8_WAIT_L(0); PG8_BAR; PG8_MMA(0, 0, At, B0); PG8_MMA(0, 1, At, B1); PG8_BAR; PG8_SCHED;
            PG8_LDA(At, 1, 1); PG8_STAGE(PG8_SB(1, 0), b3, voffB); PG8_STAGE(PG8_SB(1, 1), b3 + hstep, voffB); PG8_STAGE(PG8_SA(1, 0), a3, voffA);
            PG8_WAIT_V(8); PG8_WAIT_L(0); PG8_BAR; PG8_MMA(1, 0, At, B0); PG8_MMA(1, 1, At, B1); PG8_BAR; PG8_SCHED;
            } else {
            PG8_LDB(B0, 0, 0); PG8_SCHED; PG8_LDA(At, 0, 0); PG8_STAGE(PG8_SA(1, 1), a1 + hstep, voffA);
            PG8_WAIT_L(8); PG8_BAR; PG8_WAIT_L(0); PG8_MMA(0, 0, At, B0); PG8_BAR; PG8_SCHED;
            PG8_LDB(B1, 0, 1); PG8_STAGE(PG8_SB(0, 0), b2, voffB);
            PG8_BAR; PG8_WAIT_L(0); PG8_MMA(0, 1, At, B1); PG8_BAR;
            PG8_LDA(At, 0, 1); PG8_STAGE(PG8_SA(0, 0), a2, voffA);
            PG8_BAR; PG8_WAIT_L(0); PG8_MMA(1, 0, At, B0); PG8_BAR; PG8_SCHED;
            PG8_STAGE(PG8_SB(0, 1), b2 + hstep, voffB);
            PG8_WAIT_V(6); PG8_BAR; PG8_MMA(1, 1, At, B1); PG8_BAR;
            PG8_LDB(B0, 1, 0); PG8_SCHED; PG8_LDA(At, 1, 0); PG8_STAGE(PG8_SA(0, 1), a2 + hstep, voffA);
            PG8_WAIT_L(8); PG8_BAR; PG8_WAIT_L(0); PG8_MMA(0, 0, At, B0); PG8_BAR; PG8_SCHED;
            PG8_LDB(B1, 1, 1); PG8_STAGE(PG8_SB(1, 0), b3, voffB);
            PG8_BAR; PG8_WAIT_L(0); PG8_MMA(0, 1, At, B1); PG8_BAR;
            PG8_LDA(At, 1, 1); PG8_STAGE(PG8_SA(1, 0), a3, voffA);
            PG8_BAR; PG8_WAIT_L(0); PG8_MMA(1, 0, At, B0); PG8_BAR; PG8_SCHED;
            PG8_STAGE(PG8_SB(1, 1), b3 + hstep, voffB);
            PG8_WAIT_V(6); PG8_BAR; PG8_MMA(1, 1, At, B1); PG8_BAR;
            }
        }
        if constexpr (ALIGN_EPI) { if (wr == 0) PG8_BAR; }
        if constexpr (!Epi::AFTER_DRAIN) { E(acc, cur, wr, wc, fr, fq); S.done(cur); }
        if (!has_next) break;
#pragma unroll
        for (int a = 0; a < 2; ++a)
#pragma unroll
            for (int b = 0; b < 2; ++b)
#pragma unroll
                for (int m = 0; m < 4; ++m)
#pragma unroll
                    for (int n = 0; n < 2; ++n) acc[a][b][m][n] = (f32x4){0.f, 0.f, 0.f, 0.f};
        cur = nxt; cA = nA; cB = nB; ++ui;
        if constexpr (ALIGN_EPI) { if (wr == 1) PG8_BAR; }
    }
    PG8_WAIT_V(0);
    if constexpr (!ALIGN_EPI) { if (wr == 0) PG8_BAR; }
    PG8_BAR;
    if constexpr (Epi::AFTER_DRAIN) { E.fused(acc, cur, wr, wc, fr, fq, lds, wid, lane); S.done(cur); }
#undef PG8_SA
#undef PG8_SB
#undef PG8_STAGE
#undef PG8_LDA
#undef PG8_LDB
#undef PG8_MMA
#undef PG8_WAIT_V
#undef PG8_WAIT_L
#undef PG8_BAR
#undef PG8_SCHED
}
}

#define LAS __attribute__((address_space(3)))
using pg8::f32x4; using pg8::bf16_t; using pg8::Unit; using pg8::u32x4; using pg8::f32x2; using pg8::bf16x8;
typedef float f32x16 __attribute__((ext_vector_type(16)));
typedef short s16x4 __attribute__((ext_vector_type(4)));
typedef unsigned u32x2 __attribute__((ext_vector_type(2)));
typedef __bf16 bf16x2_t __attribute__((ext_vector_type(2)));

constexpr int T_TOK = 65536, SEQ = 2048, DM = 1024, DFF = 2816, NGU = 5632, NIN_P = 1792, NQ = 768, NKV = 1024;
constexpr float EPS = 1e-6f;
constexpr int NWAVES = 8, NTHR = 512;
constexpr int LDS_BYTES = 147456;
constexpr float QSCALE = 0.10206207261596575f * 1.4426950408889634f;

constexpr size_t MiB = 1u << 20;
constexpr size_t WS_ROPE = 1 * MiB;
constexpr size_t WS_PQ = 2 * MiB, WS_PKV = 3 * MiB, WS_PV = 4 * MiB, WS_RS = 5 * MiB;
constexpr size_t WS_W = 8 * MiB, WS_WL = 42 * MiB;
constexpr size_t WS_XN = 96 * MiB;
constexpr size_t WS_ACT = 224 * MiB;
constexpr size_t WS_ZC = 224 * MiB, WS_CQ = 320 * MiB, WS_U = 352 * MiB, WS_V = 384 * MiB, WS_CKV = 416 * MiB, WS_KR = 432 * MiB, WS_Q = 448 * MiB;
constexpr size_t WS_KV = 576 * MiB, WS_Y = 704 * MiB, WS_H = 832 * MiB, WS_END = 960 * MiB;

__device__ __forceinline__ unsigned cvtpk(float lo, float hi) { f32x2 v = {lo, hi}; bf16x2_t b = __builtin_convertvector(v, bf16x2_t); return __builtin_bit_cast(unsigned, b); }
__device__ __forceinline__ u32x4 pack8(f32x4 v0, f32x4 v1) { u32x4 w; w.x = cvtpk(v0[0], v0[1]); w.y = cvtpk(v0[2], v0[3]); w.z = cvtpk(v1[0], v1[1]); w.w = cvtpk(v1[2], v1[3]); return w; }
__device__ __forceinline__ unsigned short f2bf(float f) { unsigned u = __builtin_bit_cast(unsigned, f); return (unsigned short)((u + 0x7fffu + ((u >> 16) & 1u)) >> 16); }
__device__ __forceinline__ float bf2f(unsigned short b) { return __builtin_bit_cast(float, (unsigned)b << 16); }
__device__ __forceinline__ float bflo(unsigned w) { return __builtin_bit_cast(float, w << 16); }
__device__ __forceinline__ float bfhi(unsigned w) { return __builtin_bit_cast(float, w & 0xffff0000u); }
__device__ __forceinline__ float silu_mul(float g, float u) { return g * __builtin_amdgcn_rcpf(1.0f + __builtin_amdgcn_exp2f(-1.4426950408889634f * g)) * u; }
__device__ __forceinline__ f32x4 gelu4(f32x4 v) { f32x2 a = pg8::gelu_pk((f32x2){v[0], v[1]}), b = pg8::gelu_pk((f32x2){v[2], v[3]}); return (f32x4){a.x, a.y, b.x, b.y}; }
__device__ __forceinline__ float sumsq4(f32x4 v) { return (v[0] * v[0] + v[1] * v[1]) + (v[2] * v[2] + v[3] * v[3]); }
__device__ __forceinline__ float shflx(float v, int o, int lane) { return __builtin_bit_cast(float, __builtin_amdgcn_ds_bpermute((lane ^ o) << 2, __builtin_bit_cast(int, v))); }
__device__ __forceinline__ float wave_sum(float v, int lane) {
#pragma unroll
    for (int o = 1; o < 64; o <<= 1) v += shflx(v, o, lane);
    return v;
}

struct EpiPlain {
    static constexpr bool PERM = true, AFTER_DRAIN = false;
    bf16_t* O; int ldc;
    __device__ __forceinline__ void operator()(const f32x4 (&acc)[2][2][4][2], const Unit& u, int wr, int wc, int fr, int fq) const {
        const int row0 = u.pm * 256 + wr * 64 + fr, col0 = u.pn * 256 + wc * 32 + 8 * fq;
#pragma unroll
        for (int ai = 0; ai < 2; ++ai)
#pragma unroll
            for (int m = 0; m < 4; ++m) { bf16_t* rowp = O + (size_t)(row0 + ai * 128 + m * 16) * ldc + col0;
#pragma unroll
                for (int bj = 0; bj < 2; ++bj) *(u32x4*)(rowp + bj * 128) = pack8(acc[ai][bj][m][0], acc[ai][bj][m][1]); }
    }
};
struct EpiSwiGLU {
    static constexpr bool PERM = true, AFTER_DRAIN = false;
    bf16_t* O; const float* RS;
    __device__ __forceinline__ void operator()(const f32x4 (&acc)[2][2][4][2], const Unit& u, int wr, int wc, int fr, int fq) const {
        const int row0 = u.pm * 256 + wr * 64 + fr, col0 = u.pn * 128 + wc * 32 + 8 * fq;
#pragma unroll
        for (int ai = 0; ai < 2; ++ai)
#pragma unroll
            for (int m = 0; m < 4; ++m) {
                const f32x4 g0 = acc[ai][0][m][0], g1 = acc[ai][0][m][1], u0 = acc[ai][1][m][0], u1 = acc[ai][1][m][1];
                f32x4 r0, r1;
#pragma unroll
                for (int e = 0; e < 4; ++e) { r0[e] = silu_mul(g0[e], u0[e]); r1[e] = silu_mul(g1[e], u1[e]); }
                *(u32x4*)(O + (size_t)(row0 + ai * 128 + m * 16) * DFF + col0) = pack8(r0, r1);
            }
    }
};
struct EpiWin {
    static constexpr bool PERM = true, AFTER_DRAIN = false;
    bf16_t *ZC, *CQ, *U, *V, *CKV, *KR; float *PQ, *PV, *PKV; const float* rope; const float* RS;
    __device__ __forceinline__ void operator()(const f32x4 (&acc)[2][2][4][2], const Unit& u, int wr, int wc, int fr, int fq) const {
        const int row0 = u.pm * 256 + wr * 64 + fr, cw = wc * 32 + 8 * fq, pn = u.pn;
        if (pn < 3) {
#pragma unroll
            for (int ai = 0; ai < 2; ++ai)
#pragma unroll
                for (int m = 0; m < 4; ++m) { bf16_t* rowp = ZC + (size_t)(row0 + ai * 128 + m * 16) * 768 + pn * 256 + cw;
#pragma unroll
                    for (int bj = 0; bj < 2; ++bj) *(u32x4*)(rowp + bj * 128) = pack8(acc[ai][bj][m][0], acc[ai][bj][m][1]); }
        } else if (pn == 3) {
#pragma unroll
            for (int ai = 0; ai < 2; ++ai)
#pragma unroll
                for (int m = 0; m < 4; ++m) { const int row = row0 + ai * 128 + m * 16; bf16_t* rowp = CQ + (size_t)row * 256 + cw; float ss = 0.f;
#pragma unroll
                    for (int bj = 0; bj < 2; ++bj) { const f32x4 v0 = acc[ai][bj][m][0], v1 = acc[ai][bj][m][1]; ss += sumsq4(v0) + sumsq4(v1); *(u32x4*)(rowp + bj * 128) = pack8(v0, v1); }
                    ss += shflx(ss, 16, fq * 16 + fr); ss += shflx(ss, 32, fq * 16 + fr);
                    if (fq == 0) PQ[(size_t)row * 4 + wc] = ss; }
        } else if (pn == 4) {
#pragma unroll
            for (int ai = 0; ai < 2; ++ai)
#pragma unroll
                for (int m = 0; m < 4; ++m) { bf16_t* rowp = U + (size_t)(row0 + ai * 128 + m * 16) * 256 + cw;
#pragma unroll
                    for (int bj = 0; bj < 2; ++bj) *(u32x4*)(rowp + bj * 128) = pack8(gelu4(acc[ai][bj][m][0]), gelu4(acc[ai][bj][m][1])); }
        } else if (pn == 5) {
#pragma unroll
            for (int ai = 0; ai < 2; ++ai)
#pragma unroll
                for (int m = 0; m < 4; ++m) { const int row = row0 + ai * 128 + m * 16; bf16_t* rowp = V + (size_t)row * 256 + cw; float ss = 0.f;
#pragma unroll
                    for (int bj = 0; bj < 2; ++bj) { const f32x4 v0 = gelu4(acc[ai][bj][m][0]), v1 = gelu4(acc[ai][bj][m][1]); ss += sumsq4(v0) + sumsq4(v1); *(u32x4*)(rowp + bj * 128) = pack8(v0, v1); }
                    ss += shflx(ss, 16, fq * 16 + fr); ss += shflx(ss, 32, fq * 16 + fr);
                    if (fq == 0) PV[(size_t)row * 4 + wc] = ss; }
        } else {
#pragma unroll
            for (int ai = 0; ai < 2; ++ai)
#pragma unroll
                for (int m = 0; m < 4; ++m) { const int row = row0 + ai * 128 + m * 16;
                    const f32x4 v0 = acc[ai][0][m][0], v1 = acc[ai][0][m][1]; float ss = sumsq4(v0) + sumsq4(v1);
                    *(u32x4*)(CKV + (size_t)row * 128 + cw) = pack8(v0, v1);
                    ss += shflx(ss, 16, fq * 16 + fr); ss += shflx(ss, 32, fq * 16 + fr);
                    if (fq == 0) PKV[(size_t)row * 4 + wc] = ss;
                    if (wc == 0) {
                        const f32x4 a = acc[ai][1][m][0], b = acc[ai][1][m][1];
                        const f32x4* rp = (const f32x4*)(rope + ((size_t)(row & (SEQ - 1)) * 16 + 4 * fq) * 2);
                        const f32x4 c0 = rp[0], c1 = rp[1];
                        f32x4 ra, rb;
                        ra[0] = a[0] * c0[0] - a[1] * c0[1]; ra[1] = a[1] * c0[0] + a[0] * c0[1];
                        ra[2] = a[2] * c0[2] - a[3] * c0[3]; ra[3] = a[3] * c0[2] + a[2] * c0[3];
                        rb[0] = b[0] * c1[0] - b[1] * c1[1]; rb[1] = b[1] * c1[0] + b[0] * c1[1];
                        rb[2] = b[2] * c1[2] - b[3] * c1[3]; rb[3] = b[3] * c1[2] + b[2] * c1[3];
                        *(u32x4*)(KR + (size_t)row * 32 + 8 * fq) = pack8(ra, rb);
                    } }
        }
    }
};
struct EpiUq {
    static constexpr bool PERM = true, AFTER_DRAIN = false;
    bf16_t* Q; const float* PQ; const float* rope;
    __device__ __forceinline__ void operator()(const f32x4 (&acc)[2][2][4][2], const Unit& u, int wr, int wc, int fr, int fq) const {
        const int row0 = u.pm * 256 + wr * 64 + fr, col0 = u.pn * 256 + wc * 32 + 8 * fq;
#pragma unroll
        for (int ai = 0; ai < 2; ++ai)
#pragma unroll
            for (int m = 0; m < 4; ++m) { const int row = row0 + ai * 128 + m * 16;
                const f32x4 p = *(const f32x4*)(PQ + (size_t)row * 4);
                const float sc = QSCALE / sqrtf(((p[0] + p[1]) + (p[2] + p[3])) * (1.0f / 256.0f) + EPS);
#pragma unroll
                for (int bj = 0; bj < 2; ++bj) { const int c = col0 + bj * 128, w = c % 96;
                    f32x4 a = acc[ai][bj][m][0] * sc, b = acc[ai][bj][m][1] * sc;
                    if (w >= 64) {
                        const f32x4* rp = (const f32x4*)(rope + ((size_t)(row & (SEQ - 1)) * 16 + ((w - 64) >> 1)) * 2);
                        const f32x4 c0 = rp[0], c1 = rp[1]; f32x4 ra, rb;
                        ra[0] = a[0] * c0[0] - a[1] * c0[1]; ra[1] = a[1] * c0[0] + a[0] * c0[1];
                        ra[2] = a[2] * c0[2] - a[3] * c0[3]; ra[3] = a[3] * c0[2] + a[2] * c0[3];
                        rb[0] = b[0] * c1[0] - b[1] * c1[1]; rb[1] = b[1] * c1[0] + b[0] * c1[1];
                        rb[2] = b[2] * c1[2] - b[3] * c1[3]; rb[3] = b[3] * c1[2] + b[2] * c1[3];
                        a = ra; b = rb;
                    }
                    *(u32x4*)(Q + (size_t)row * NQ + c) = pack8(a, b); } }
    }
};
struct EpiUkv {
    static constexpr bool PERM = true, AFTER_DRAIN = false;
    bf16_t* KV; const float* PKV;
    __device__ __forceinline__ void operator()(const f32x4 (&acc)[2][2][4][2], const Unit& u, int wr, int wc, int fr, int fq) const {
        const int row0 = u.pm * 256 + wr * 64 + fr, col0 = u.pn * 256 + wc * 32 + 8 * fq;
#pragma unroll
        for (int ai = 0; ai < 2; ++ai)
#pragma unroll
            for (int m = 0; m < 4; ++m) { const int row = row0 + ai * 128 + m * 16;
                const f32x4 p = *(const f32x4*)(PKV + (size_t)row * 4);
                const float sc = 1.0f / sqrtf(((p[0] + p[1]) + (p[2] + p[3])) * (1.0f / 128.0f) + EPS);
#pragma unroll
                for (int bj = 0; bj < 2; ++bj) *(u32x4*)(KV + (size_t)row * NKV + col0 + bj * 128) = pack8(acc[ai][bj][m][0] * sc, acc[ai][bj][m][1] * sc); }
    }
};

struct MapId   { __device__ __forceinline__ int operator()(int n) const { return n; } };
struct MapGU   { __device__ __forceinline__ int operator()(int n) const { const int pn = n >> 8, w = n & 255; return w < 128 ? 128 * pn + w : DFF + 128 * pn + (w - 128); } };
struct MapIn   { __device__ __forceinline__ int operator()(int n) const {
    if (n < 1024) return n;
    if (n < 1280) return 1184 + (n - 1024);
    if (n < 1536) return 1440 + (n - 1280);
    if (n < 1664) return 1024 + (n - 1536);
    if (n < 1696) { const int j = n - 1664; return 1152 + (j >> 1) + 16 * (j & 1); }
    return -1; } };
struct MapUq   { __device__ __forceinline__ int operator()(int n) const { const int h = n / 96, w = n % 96; if (w < 64) return n; const int j = w - 64; return h * 96 + 64 + (j >> 1) + 16 * (j & 1); } };

template <class Map>
__device__ __forceinline__ void transpose_item(const float* __restrict__ W, int K, int Nsrc, bf16_t* __restrict__ WT, int Ndst, const float* __restrict__ gk, LAS float* scr, int item, int lane, Map map) {
    const int nblk = Ndst / 32, kb = item / nblk, nb = item % nblk, k0 = 64 * kb, n0 = 32 * nb;
    const int n4 = 4 * (lane & 7), ko = lane >> 3;
    const int s0 = map(n0 + n4), s1 = map(n0 + n4 + 1), s2 = map(n0 + n4 + 2), s3 = map(n0 + n4 + 3);
    const bool contig = (s0 >= 0) && (s1 == s0 + 1) && (s2 == s0 + 2) && (s3 == s0 + 3) && ((s0 & 3) == 0);
#pragma unroll
    for (int i = 0; i < 8; ++i) { const int kk = 8 * i + ko; f32x4 v = {0.f, 0.f, 0.f, 0.f};
        const float* wr = W + (size_t)(k0 + kk) * Nsrc;
        if (contig) v = *(const f32x4*)(wr + s0);
        else { if (s0 >= 0) v[0] = wr[s0]; if (s1 >= 0) v[1] = wr[s1]; if (s2 >= 0) v[2] = wr[s2]; if (s3 >= 0) v[3] = wr[s3]; }
        if (gk) v = v * gk[k0 + kk];
        LAS float* d = scr + kk * 33 + n4; d[0] = v[0]; d[1] = v[1]; d[2] = v[2]; d[3] = v[3]; }
    asm volatile("s_waitcnt lgkmcnt(0)" ::: "memory");
    const int c = lane & 7;
#pragma unroll
    for (int j = 0; j < 4; ++j) { const int n = (lane >> 3) + 8 * j; const LAS float* s = scr + (8 * c) * 33 + n;
        u32x4 o; o.x = cvtpk(s[0 * 33], s[1 * 33]); o.y = cvtpk(s[2 * 33], s[3 * 33]); o.z = cvtpk(s[4 * 33], s[5 * 33]); o.w = cvtpk(s[6 * 33], s[7 * 33]);
        *(u32x4*)(WT + (size_t)(n0 + n) * K + k0 + 8 * c) = o; }
    asm volatile("s_waitcnt lgkmcnt(0)" ::: "memory");
}

struct Args { const float* in[22]; float* out; unsigned char* ws; int ph_lo, ph_hi; };

__device__ __forceinline__ bf16_t* wptr(unsigned char* ws, int layer, size_t off) { return (bf16_t*)(ws + WS_W + (size_t)layer * WS_WL + off); }
constexpr size_t OFF_GU1 = 0, OFF_GU2 = 11 * MiB, OFF_DN1 = 22 * MiB, OFF_DN2 = 28 * MiB, OFF_IN = 34 * MiB, OFF_OUT = 38 * MiB,
                 OFF_UQ = 40 * MiB, OFF_UKV = 40 * MiB + 512 * 1024, OFF_GWS = 41 * MiB;

__device__ __forceinline__ void rope_table(float* rope, int gtid, int gthreads) {
    for (int idx = gtid; idx < SEQ * 16; idx += gthreads) {
        const int pos = idx >> 4, i = idx & 15;
        const float inv = 1.0f / exp2f((float)i * 0.8304820237218406f);
        const float ang = (float)pos * inv;
        const double rev = (double)ang * 0.15915494309189535;
        const float fr = (float)(rev - __builtin_rint(rev));
        rope[2 * idx] = __builtin_amdgcn_cosf(fr); rope[2 * idx + 1] = __builtin_amdgcn_sinf(fr);
    }
}
__device__ __forceinline__ void prologue_weights(const Args& a, unsigned char* ws_, LAS unsigned char* lds, int gw, int NGW, int wave, int lane) {
    LAS float* scr = (LAS float*)(lds + wave * 16384);
    constexpr int I_GU = 16 * (NGU / 32), I_DN = (DFF / 64) * 32, I_IN = 16 * (NIN_P / 32), I_UQ = 4 * (NQ / 32), I_UKV = 2 * 32, I_OUT = 16 * 32;
    constexpr int PER_LAYER = 2 * I_GU + 2 * I_DN + I_IN + I_UQ + I_UKV + I_OUT;
    for (int it = gw; it < 2 * PER_LAYER; it += NGW) {
        const int l = it / PER_LAYER; int r = it % PER_LAYER;
        if (r < I_GU) { transpose_item(a.in[2] + (size_t)l * DM * NGU, DM, NGU, wptr(ws_, l, OFF_GU1), NGU, a.in[1] + l * DM, scr, r, lane, MapGU()); continue; } r -= I_GU;
        if (r < I_GU) { transpose_item(a.in[19] + (size_t)l * DM * NGU, DM, NGU, wptr(ws_, l, OFF_GU2), NGU, a.in[18] + l * DM, scr, r, lane, MapGU()); continue; } r -= I_GU;
        if (r < I_DN) { transpose_item(a.in[3] + (size_t)l * DFF * DM, DFF, DM, wptr(ws_, l, OFF_DN1), DM, nullptr, scr, r, lane, MapId()); continue; } r -= I_DN;
        if (r < I_DN) { transpose_item(a.in[20] + (size_t)l * DFF * DM, DFF, DM, wptr(ws_, l, OFF_DN2), DM, nullptr, scr, r, lane, MapId()); continue; } r -= I_DN;
        if (r < I_IN) { transpose_item(a.in[6] + (size_t)l * DM * 1696, DM, 1696, wptr(ws_, l, OFF_IN), NIN_P, a.in[5] + l * DM, scr, r, lane, MapIn()); continue; } r -= I_IN;
        if (r < I_UQ) { transpose_item(a.in[10] + (size_t)l * 256 * NQ, 256, NQ, wptr(ws_, l, OFF_UQ), NQ, a.in[9] + l * 256, scr, r, lane, MapUq()); continue; } r -= I_UQ;
        if (r < I_UKV) { transpose_item(a.in[12] + (size_t)l * 128 * NKV, 128, NKV, wptr(ws_, l, OFF_UKV), NKV, a.in[11] + l * 128, scr, r, lane, MapId()); continue; } r -= I_UKV;
        transpose_item(a.in[16] + (size_t)l * DM * DM, DM, DM, wptr(ws_, l, OFF_OUT), DM, nullptr, scr, r, lane, MapId());
    }
    for (int idx = (gw * 64 + lane); idx < 2 * 4 * 128 * 128 / 4; idx += NGW * 64) {
        const int l = idx / (4 * 128 * 128 / 4), e = idx % (4 * 128 * 128 / 4);
        const f32x4 v = *(const f32x4*)(a.in[14] + (size_t)l * 65536 + 4 * e);
        u32x2 o; o.x = cvtpk(v[0], v[1]); o.y = cvtpk(v[2], v[3]);
        *(u32x2*)(wptr(ws_, l, OFF_GWS) + 4 * e) = o;
    }
}

constexpr int RP = 4;
__device__ __forceinline__ void wave_sum4(float (&s)[RP], int lane) {
#pragma unroll
    for (int o = 1; o < 64; o <<= 1) {
        float t[RP];
#pragma unroll
        for (int k = 0; k < RP; ++k) t[k] = shflx(s[k], o, lane);
#pragma unroll
        for (int k = 0; k < RP; ++k) s[k] += t[k];
    }
}
__device__ __forceinline__ void bf8_to_f32(const u32x4 w, f32x4& a, f32x4& b) { a = (f32x4){bflo(w.x), bfhi(w.x), bflo(w.y), bfhi(w.y)}; b = (f32x4){bflo(w.z), bfhi(w.z), bflo(w.w), bfhi(w.w)}; }
__device__ __forceinline__ void row_pass(const float* __restrict__ xf, const bf16_t* xb, const bf16_t* __restrict__ H, float coef, const float* __restrict__ gpost,
                                         float* __restrict__ xout, bf16_t* XB, float* SC, int gw, int NGW, int lane) {
    f32x4 gp[2][2];
#pragma unroll
    for (int j = 0; j < 2; ++j)
#pragma unroll
        for (int q = 0; q < 2; ++q) gp[j][q] = H ? *(const f32x4*)(gpost + 8 * lane + 512 * j + 4 * q) * coef : (f32x4){0.f, 0.f, 0.f, 0.f};
#define RP_ROW0(rit_) ((NGW * RP == 8192) ? (32 * (4 * (((rit_) >> 13) & 1) + ((((rit_) & 8191) >> 8) >> 3)) + 8 * (3 - ((rit_) >> 14)) + ((((rit_) & 8191) >> 8) & 7)) * 256 + ((rit_) & 255) : (rit_))
    if (!xf && H) {
        u32x4 xw[RP][2], hw[RP][2]; float scv[RP];
        int rit = gw * RP, row0 = RP_ROW0(rit);
#pragma unroll
        for (int k = 0; k < RP; ++k) { scv[k] = SC[row0 + k];
#pragma unroll
            for (int j = 0; j < 2; ++j) { xw[k][j] = *(const u32x4*)(xb + (size_t)(row0 + k) * DM + 8 * lane + 512 * j); hw[k][j] = *(const u32x4*)(H + (size_t)(row0 + k) * DM + 8 * lane + 512 * j); } }
#pragma unroll 1
        for (; rit < T_TOK; rit += NGW * RP) {
            const int rnx = rit + NGW * RP; const bool more = rnx < T_TOK; const int row1 = more ? RP_ROW0(rnx) : row0;
            u32x4 xn_[RP][2], hn_[RP][2]; float scn[RP];
#pragma unroll
            for (int k = 0; k < RP; ++k) { scn[k] = SC[row1 + k];
#pragma unroll
                for (int j = 0; j < 2; ++j) { xn_[k][j] = *(const u32x4*)(xb + (size_t)(row1 + k) * DM + 8 * lane + 512 * j); hn_[k][j] = *(const u32x4*)(H + (size_t)(row1 + k) * DM + 8 * lane + 512 * j); } }
            f32x4 v[RP][2][2]; float ss[RP];
#pragma unroll
            for (int k = 0; k < RP; ++k) { ss[k] = 0.f;
#pragma unroll
                for (int j = 0; j < 2; ++j) { f32x4 h0, h1; bf8_to_f32(hw[k][j], h0, h1); ss[k] += sumsq4(h0) + sumsq4(h1); } }
            wave_sum4(ss, lane);
#pragma unroll
            for (int k = 0; k < RP; ++k) { const float rstd = 1.0f / sqrtf(ss[k] * (1.0f / DM) + EPS);
#pragma unroll
                for (int j = 0; j < 2; ++j) { f32x4 h0, h1, x0, x1; bf8_to_f32(hw[k][j], h0, h1); bf8_to_f32(xw[k][j], x0, x1);
                    v[k][j][0] = x0 * scv[k] + h0 * rstd * gp[j][0]; v[k][j][1] = x1 * scv[k] + h1 * rstd * gp[j][1]; } }
            if (xout) {
#pragma unroll
                for (int k = 0; k < RP; ++k)
#pragma unroll
                    for (int j = 0; j < 2; ++j)
#pragma unroll
                        for (int q = 0; q < 2; ++q) *(f32x4*)(xout + (size_t)(row0 + k) * DM + 8 * lane + 512 * j + 4 * q) = v[k][j][q];
            }
            if (XB) {
#pragma unroll
                for (int k = 0; k < RP; ++k) { ss[k] = 0.f;
#pragma unroll
                    for (int j = 0; j < 2; ++j) ss[k] += sumsq4(v[k][j][0]) + sumsq4(v[k][j][1]); }
                wave_sum4(ss, lane);
#pragma unroll
                for (int k = 0; k < RP; ++k) { const float ms = ss[k] * (1.0f / DM) + EPS; const float rstd = 1.0f / sqrtf(ms);
#pragma unroll
                    for (int j = 0; j < 2; ++j) *(u32x4*)(XB + (size_t)(row0 + k) * DM + 8 * lane + 512 * j) = pack8(v[k][j][0] * rstd, v[k][j][1] * rstd);
                    if (lane == 0) SC[row0 + k] = sqrtf(ms); }
            }
#pragma unroll
            for (int k = 0; k < RP; ++k) { scv[k] = scn[k];
#pragma unroll
                for (int j = 0; j < 2; ++j) { xw[k][j] = xn_[k][j]; hw[k][j] = hn_[k][j]; } }
            row0 = row1;
        }
        return;
    }
#pragma unroll 1
    for (int rit = gw * RP; rit < T_TOK; rit += NGW * RP) {
        int row0 = rit;
        if (NGW * RP == 8192) { const int j = rit >> 13, li = rit & 8191, pl = li >> 8; row0 = (32 * (4 * (j & 1) + (pl >> 3)) + 8 * (3 - (j >> 1)) + (pl & 7)) * 256 + (li & 255); }
        f32x4 v[RP][2][2]; u32x4 hw[RP][2];
        if (xf) {
#pragma unroll
            for (int k = 0; k < RP; ++k)
#pragma unroll
                for (int j = 0; j < 2; ++j)
#pragma unroll
                    for (int q = 0; q < 2; ++q) v[k][j][q] = *(const f32x4*)(xf + (size_t)(row0 + k) * DM + 8 * lane + 512 * j + 4 * q);
        } else {
#pragma unroll
            for (int k = 0; k < RP; ++k) { const float sc = SC[row0 + k];
#pragma unroll
                for (int j = 0; j < 2; ++j) { const u32x4 w = *(const u32x4*)(xb + (size_t)(row0 + k) * DM + 8 * lane + 512 * j); bf8_to_f32(w, v[k][j][0], v[k][j][1]); v[k][j][0] = v[k][j][0] * sc; v[k][j][1] = v[k][j][1] * sc; } }
        }
        if (H) {
#pragma unroll
            for (int k = 0; k < RP; ++k)
#pragma unroll
                for (int j = 0; j < 2; ++j) hw[k][j] = *(const u32x4*)(H + (size_t)(row0 + k) * DM + 8 * lane + 512 * j);
            float ss[RP];
#pragma unroll
            for (int k = 0; k < RP; ++k) { ss[k] = 0.f;
#pragma unroll
                for (int j = 0; j < 2; ++j) { f32x4 h0, h1; bf8_to_f32(hw[k][j], h0, h1); ss[k] += sumsq4(h0) + sumsq4(h1); } }
            wave_sum4(ss, lane);
#pragma unroll
            for (int k = 0; k < RP; ++k) { const float rstd = 1.0f / sqrtf(ss[k] * (1.0f / DM) + EPS);
#pragma unroll
                for (int j = 0; j < 2; ++j) { f32x4 h0, h1; bf8_to_f32(hw[k][j], h0, h1); v[k][j][0] = v[k][j][0] + h0 * rstd * gp[j][0]; v[k][j][1] = v[k][j][1] + h1 * rstd * gp[j][1]; } }
        }
        if (xout) {
#pragma unroll
            for (int k = 0; k < RP; ++k)
#pragma unroll
                for (int j = 0; j < 2; ++j)
#pragma unroll
                    for (int q = 0; q < 2; ++q) *(f32x4*)(xout + (size_t)(row0 + k) * DM + 8 * lane + 512 * j + 4 * q) = v[k][j][q];
        }
        if (XB) {
            float ss[RP];
#pragma unroll
            for (int k = 0; k < RP; ++k) { ss[k] = 0.f;
#pragma unroll
                for (int j = 0; j < 2; ++j) ss[k] += sumsq4(v[k][j][0]) + sumsq4(v[k][j][1]); }
            wave_sum4(ss, lane);
#pragma unroll
            for (int k = 0; k < RP; ++k) { const float ms = ss[k] * (1.0f / DM) + EPS; const float rstd = 1.0f / sqrtf(ms);
#pragma unroll
                for (int j = 0; j < 2; ++j) *(u32x4*)(XB + (size_t)(row0 + k) * DM + 8 * lane + 512 * j) = pack8(v[k][j][0] * rstd, v[k][j][1] * rstd);
                if (lane == 0) SC[row0 + k] = sqrtf(ms); }
        }
    }
}

__device__ __forceinline__ void unpack8(const u32x4 w, float (&o)[8]) { o[0] = bflo(w.x); o[1] = bfhi(w.x); o[2] = bflo(w.y); o[3] = bfhi(w.y); o[4] = bflo(w.z); o[5] = bfhi(w.z); o[6] = bflo(w.w); o[7] = bfhi(w.w); }
__device__ __forceinline__ void conv_phase(const bf16_t* __restrict__ ZC, const float* __restrict__ cw, const float* __restrict__ cb, bf16_t* __restrict__ Y, int gtid, int gthreads) {
    for (int item = gtid; item < (T_TOK / 16) * 32; item += gthreads) {
        const int ch = item & 31, rb = item >> 5, t0 = rb * 16, c0 = ch * 8;
        float w0[8], w1[8], w2[8], bb[8];
#pragma unroll
        for (int e = 0; e < 8; ++e) { w0[e] = cw[c0 + e]; w1[e] = cw[256 + c0 + e]; w2[e] = cw[512 + c0 + e]; bb[e] = cb[c0 + e]; }
        float zp[8], zc[8], zn[8];
        {
            if ((t0 & (SEQ - 1)) != 0) { float x[8], g[8]; unpack8(*(const u32x4*)(ZC + (size_t)(t0 - 1) * 768 + c0), x); unpack8(*(const u32x4*)(ZC + (size_t)(t0 - 1) * 768 + 512 + c0), g);
#pragma unroll
                for (int e = 0; e < 8; ++e) zp[e] = x[e] * g[e]; }
            else {
#pragma unroll
                for (int e = 0; e < 8; ++e) zp[e] = 0.f; }
            float x[8], g[8]; unpack8(*(const u32x4*)(ZC + (size_t)t0 * 768 + c0), x); unpack8(*(const u32x4*)(ZC + (size_t)t0 * 768 + 512 + c0), g);
#pragma unroll
            for (int e = 0; e < 8; ++e) zc[e] = x[e] * g[e];
        }
        for (int i = 0; i < 16; ++i) {
            const int t = t0 + i;
            if (((t + 1) & (SEQ - 1)) != 0) { float x[8], g[8]; unpack8(*(const u32x4*)(ZC + (size_t)(t + 1) * 768 + c0), x); unpack8(*(const u32x4*)(ZC + (size_t)(t + 1) * 768 + 512 + c0), g);
#pragma unroll
                for (int e = 0; e < 8; ++e) zn[e] = x[e] * g[e]; }
            else {
#pragma unroll
                for (int e = 0; e < 8; ++e) zn[e] = 0.f; }
            float gbv[8]; unpack8(*(const u32x4*)(ZC + (size_t)t * 768 + 256 + c0), gbv);
            float o[8];
#pragma unroll
            for (int e = 0; e < 8; ++e) o[e] = gbv[e] * (w0[e] * zp[e] + w1[e] * zc[e] + w2[e] * zn[e] + bb[e]);
            u32x4 w; w.x = cvtpk(o[0], o[1]); w.y = cvtpk(o[2], o[3]); w.z = cvtpk(o[4], o[5]); w.w = cvtpk(o[6], o[7]);
            *(u32x4*)(Y + (size_t)t * DM + c0) = w;
#pragma unroll
            for (int e = 0; e < 8; ++e) { zp[e] = zc[e]; zc[e] = zn[e]; }
        }
    }
}

__device__ __forceinline__ int lane_id() { int l; asm volatile("v_mbcnt_lo_u32_b32 %0, -1, 0\n\tv_mbcnt_hi_u32_b32 %0, -1, %0" : "=v"(l)); return l; }
#define MFMA32(a, b, c) __builtin_amdgcn_mfma_f32_32x32x16_bf16((a), (b), (c), 0, 0, 0)
__device__ __forceinline__ int crow(int i, int h) { return (i & 3) + 8 * (i >> 2) + 4 * h; }
template <int S> __device__ __forceinline__ bf16x8 packstep(const f32x16& x) {
    u32x4 p; p.x = cvtpk(x[8 * S], x[8 * S + 1]); p.y = cvtpk(x[8 * S + 2], x[8 * S + 3]); p.z = cvtpk(x[8 * S + 4], x[8 * S + 5]); p.w = cvtpk(x[8 * S + 6], x[8 * S + 7]);
    return __builtin_bit_cast(bf16x8, p);
}
typedef short v4i16_t __attribute__((ext_vector_type(4)));
__device__ __forceinline__ s16x4 tr_read(LAS unsigned char* p) { return __builtin_bit_cast(s16x4, __builtin_amdgcn_ds_read_tr16_b64_v4i16((LAS v4i16_t*)p)); }

constexpr int GM_PITCH = 272;
__device__ __forceinline__ void gmlp_phase(LAS unsigned char* lds, const bf16_t* __restrict__ U, const bf16_t* __restrict__ V, const float* __restrict__ PV, const float* __restrict__ gng,
                                           const bf16_t* __restrict__ WS, const float* __restrict__ bias, bf16_t* __restrict__ Y, int gw, int NGW, int wave, int lane) {
    LAS unsigned char* vt = lds + wave * (64 * GM_PITCH);
    const int r = lane & 31, hh = lane >> 5;
    for (int unit = gw; unit < 2048; unit += NGW) {
        const int g = unit & 3, bc = unit >> 2; const size_t row0 = (size_t)bc * 128;
        {
            const int ch = lane & 7; float gn[8];
#pragma unroll
            for (int e = 0; e < 8; ++e) gn[e] = gng[g * 64 + ch * 8 + e];
#pragma unroll 4
            for (int it = 0; it < 16; ++it) {
                const int q = it * 8 + (lane >> 3);
                const f32x4 p = *(const f32x4*)(PV + (row0 + q) * 4);
                const float rstd = 1.0f / sqrtf(((p[0] + p[1]) + (p[2] + p[3])) * (1.0f / 256.0f) + EPS);
                float x[8]; unpack8(*(const u32x4*)(V + (row0 + q) * 256 + g * 64 + ch * 8), x);
#pragma unroll
                for (int e = 0; e < 8; ++e) *(LAS unsigned short*)(vt + (ch * 8 + e) * GM_PITCH + q * 2) = f2bf(x[e] * rstd * gn[e]);
            }
        }
        asm volatile("s_waitcnt lgkmcnt(0)" ::: "memory");
        bf16x8 bfr[2][8];
#pragma unroll
        for (int dt = 0; dt < 2; ++dt)
#pragma unroll
            for (int ks = 0; ks < 8; ++ks) bfr[dt][ks] = *(LAS bf16x8*)(vt + (32 * dt + r) * GM_PITCH + (16 * ks + 8 * hh) * 2);
#pragma unroll 1
        for (int pt = 0; pt < 4; ++pt) {
            f32x16 o0 = {}, o1 = {};
            const bf16_t* wp = WS + ((size_t)(g * 128 + 32 * pt + r)) * 128 + 8 * hh;
#pragma unroll
            for (int ks = 0; ks < 8; ++ks) { const bf16x8 af = *(const bf16x8*)(wp + 16 * ks); o0 = MFMA32(bfr[0][ks], af, o0); o1 = MFMA32(bfr[1][ks], af, o1); }
            { const int pp = 32 * pt + r; const float bs = bias[g * 128 + pp];
              const bf16_t* up = U + (row0 + pp) * 256 + g * 64 + 4 * hh; bf16_t* yp = Y + (row0 + pp) * DM + 768 + g * 64 + 4 * hh;
#pragma unroll
              for (int q4 = 0; q4 < 4; ++q4) {
                  const u32x2 u0 = *(const u32x2*)(up + 8 * q4), u1 = *(const u32x2*)(up + 32 + 8 * q4);
                  u32x2 w0, w1;
                  w0.x = cvtpk(bflo(u0.x) * (o0[4 * q4] + bs), bfhi(u0.x) * (o0[4 * q4 + 1] + bs)); w0.y = cvtpk(bflo(u0.y) * (o0[4 * q4 + 2] + bs), bfhi(u0.y) * (o0[4 * q4 + 3] + bs));
                  w1.x = cvtpk(bflo(u1.x) * (o1[4 * q4] + bs), bfhi(u1.x) * (o1[4 * q4 + 1] + bs)); w1.y = cvtpk(bflo(u1.y) * (o1[4 * q4 + 2] + bs), bfhi(u1.y) * (o1[4 * q4 + 3] + bs));
                  *(u32x2*)(yp + 8 * q4) = w0; *(u32x2*)(yp + 32 + 8 * q4) = w1; } }
        }
        asm volatile("s_waitcnt lgkmcnt(0)" ::: "memory");
    }
}

__device__ __forceinline__ float xhalf_max(float m) { float a = m, b = m; asm volatile("v_nop\n\tv_nop\n\tv_permlane32_swap_b32 %0, %1" : "+v"(a), "+v"(b)); return fmaxf(a, b); }
__device__ __forceinline__ float xhalf_sum(float m) { float a = m, b = m; asm volatile("v_nop\n\tv_nop\n\tv_permlane32_swap_b32 %0, %1" : "+v"(a), "+v"(b)); return a + b; }
constexpr int AT_KP = 208, AT_VP = 144, AT_KB = 64 * AT_KP, AT_VB = 64 * AT_VP, AT_STAGE = AT_KB + AT_VB;
constexpr int AT_WSF = 2 * AT_STAGE, AT_QOFF = AT_WSF + 8 * 64 * 4, AT_QW = 64 * 192;
static_assert(AT_QOFF + 8 * AT_QW <= LDS_BYTES - 64, "attention LDS map");
#define FMAX2(a, b) __builtin_amdgcn_fmed3f((a), (b), __builtin_inff())
#define AT_SOFTMAX(s0, s1, m_run, l_run, oA, oB, wsfp) do { \
        float tmax = FMAX2(s0[0], s1[0]); \
        _Pragma("unroll") for (int i = 1; i < 16; ++i) tmax = FMAX2(tmax, FMAX2(s0[i], s1[i])); \
        tmax = xhalf_max(tmax); \
        if (__any(tmax > m_run + 8.0f)) { \
            const float m_new = fmaxf(m_run, tmax); const float f = __builtin_amdgcn_exp2f(m_run - m_new); m_run = m_new; l_run *= f; \
            if (hh == 0) (wsfp)[r] = f; \
            asm volatile("s_waitcnt lgkmcnt(0)" ::: "memory"); \
            _Pragma("unroll") for (int i = 0; i < 16; ++i) { const float fi = ((wsfp) + 4 * hh)[(i & 3) + 8 * (i >> 2)]; oA[i] *= fi; oB[i] *= fi; } \
        } \
        float ps = 0.f; \
        _Pragma("unroll") for (int i = 0; i < 16; ++i) { s0[i] = __builtin_amdgcn_exp2f(s0[i] - m_run); s1[i] = __builtin_amdgcn_exp2f(s1[i] - m_run); ps += s0[i] + s1[i]; } \
        l_run += ps; } while (0)

__device__ __forceinline__ void attn_phase(LAS unsigned char* lds, const bf16_t* __restrict__ Q, const bf16_t* __restrict__ KV, const bf16_t* __restrict__ KR, bf16_t* __restrict__ Y, int vcu, int G, const int tid) {
    const int lane = tid & 63, wid = __builtin_amdgcn_readfirstlane(tid >> 6), r = lane & 31, hh = lane >> 5;
    const int srow = tid >> 3, sch = tid & 7, rrow = (tid >> 2) & 63, rch = tid & 3;
    LAS float* wsf = (LAS float*)(lds + AT_WSF) + wid * 64;
    LAS unsigned char* qimg = lds + AT_QOFF + wid * AT_QW;
    const int i16 = lane & 15, tq = i16 >> 2, tp = i16 & 3, blk = (lane >> 4) & 1;
    const int voff = (4 * hh + tq) * AT_VP + blk * 32 + tp * 8;
    const int qsw = (r >> 2) & 3;
    for (int bh = vcu; bh < 256; bh += G) {
        const int b = bh >> 3, h = bh & 7; const size_t rowbase = (size_t)b * SEQ;
        const bf16_t* kvsrc = KV + (rowbase + srow) * NKV + h * 128 + sch * 8;
        const bf16_t* krsrc = KR + (rowbase + rrow) * 32 + rch * 8;
#pragma unroll 1
        for (int qb = 0; qb < 4; ++qb) {
            {
                const bf16_t* qsrc = Q + (rowbase + qb * 512 + wid * 64 + lane) * NQ + h * 96;
                const int key = (lane >> 2) & 3;
#pragma unroll
                for (int bq = 0; bq < 4; ++bq) { LAS unsigned char* dst = qimg + lane * 192 + ((bq ^ key) << 4);
#pragma unroll
                    for (int aq = 0; aq < 3; ++aq) *(LAS u32x4*)(dst + 64 * aq) = *(const u32x4*)(qsrc + (4 * aq + bq) * 8); }
            }
            u32x4 gk = *(const u32x4*)(kvsrc), gv = *(const u32x4*)(kvsrc + 64), gr = (u32x4){0u, 0u, 0u, 0u};
            if (tid < 256) gr = *(const u32x4*)(krsrc);
            float ma = -1e30f, la = 0.f, mb = -1e30f, lb = 0.f; f32x16 oa0 = {}, oa1 = {}, ob0 = {}, ob1 = {};
#pragma unroll 1
            for (int t = 0; t < SEQ / 64; ++t) {
                LAS unsigned char* kb = lds + (t & 1) * AT_STAGE; LAS unsigned char* vb = kb + AT_KB;
                *(LAS u32x4*)(kb + srow * AT_KP + sch * 16) = gk;
                *(LAS u32x4*)(vb + srow * AT_VP + sch * 16) = gv;
                if (tid < 256) *(LAS u32x4*)(kb + rrow * AT_KP + 128 + rch * 16) = gr;
                __syncthreads();
                if (t + 1 < SEQ / 64) { const size_t adv = (size_t)(t + 1) * 64;
                    gk = *(const u32x4*)(kvsrc + adv * NKV); gv = *(const u32x4*)(kvsrc + adv * NKV + 64);
                    if (tid < 256) gr = *(const u32x4*)(krsrc + adv * 32); }
                f32x16 sa0 = {}, sa1 = {}, sb0 = {}, sb1 = {};
#pragma unroll
                for (int ks = 0; ks < 6; ++ks) {
                    const bf16x8 k0 = *(LAS bf16x8*)(kb + r * AT_KP + ks * 32 + hh * 16);
                    const bf16x8 k1 = *(LAS bf16x8*)(kb + (32 + r) * AT_KP + ks * 32 + hh * 16);
                    const int qc = ((2 * ks + hh) ^ qsw) << 4;
                    const bf16x8 qa = *(LAS bf16x8*)(qimg + r * 192 + qc);
                    const bf16x8 qb2 = *(LAS bf16x8*)(qimg + (32 + r) * 192 + qc);
                    sa0 = MFMA32(k0, qa, sa0); sa1 = MFMA32(k1, qa, sa1);
                    sb0 = MFMA32(k0, qb2, sb0); sb1 = MFMA32(k1, qb2, sb1);
                }
                AT_SOFTMAX(sa0, sa1, ma, la, oa0, oa1, wsf);
                const bf16x8 pa00 = packstep<0>(sa0), pa01 = packstep<1>(sa0), pa10 = packstep<0>(sa1), pa11 = packstep<1>(sa1);
                AT_SOFTMAX(sb0, sb1, mb, lb, ob0, ob1, wsf + 32);
                const bf16x8 pb00 = packstep<0>(sb0), pb01 = packstep<1>(sb0), pb10 = packstep<0>(sb1), pb11 = packstep<1>(sb1);
#define PVSTEP(pa, pb, kv0) do { \
                    const s16x4 l0 = tr_read(vb + (kv0) * AT_VP + voff), h0 = tr_read(vb + ((kv0) + 8) * AT_VP + voff); \
                    const s16x4 l1 = tr_read(vb + (kv0) * AT_VP + voff + 64), h1 = tr_read(vb + ((kv0) + 8) * AT_VP + voff + 64); \
                    const bf16x8 v0 = __builtin_shufflevector(l0, h0, 0, 1, 2, 3, 4, 5, 6, 7), v1 = __builtin_shufflevector(l1, h1, 0, 1, 2, 3, 4, 5, 6, 7); \
                    oa0 = MFMA32(pa, v0, oa0); oa1 = MFMA32(pa, v1, oa1); ob0 = MFMA32(pb, v0, ob0); ob1 = MFMA32(pb, v1, ob1); } while (0)
                PVSTEP(pa00, pb00, 0); PVSTEP(pa01, pb01, 16); PVSTEP(pa10, pb10, 32); PVSTEP(pa11, pb11, 48);
#undef PVSTEP
            }
            const float lta = xhalf_sum(la), ltb = xhalf_sum(lb);
            if (hh == 0) { wsf[r] = 1.0f / lta; wsf[32 + r] = 1.0f / ltb; }
            asm volatile("s_waitcnt lgkmcnt(0)" ::: "memory");
            bf16_t* yp = Y + (rowbase + qb * 512 + wid * 64 + 4 * hh) * DM + 256 + h * 64 + r;
            asm volatile("" : "+v"(yp));
            LAS float* wsfh = wsf + 4 * hh;
#pragma unroll
            for (int i = 0; i < 16; ++i) { const int q = (i & 3) + 8 * (i >> 2); const float fa = wsfh[q], fb = wsfh[32 + q];
                yp[(size_t)q * DM] = f2bf(oa0[i] * fa); yp[(size_t)q * DM + 32] = f2bf(oa1[i] * fa);
                yp[(size_t)(32 + q) * DM] = f2bf(ob0[i] * fb); yp[(size_t)(32 + q) * DM + 32] = f2bf(ob1[i] * fb); }
            __syncthreads();
        }
    }
}

#define XB_TMO      128
#define XB_XCNT(j)  (256  + 64 * (j))
#define XB_XSUB(j)  (1280 + 64 * (j))
#define XB_XGEN(j)  (2304 + 64 * (j))
#define XB_TOP      3328
#define XB_TOPGEN   3392
#define XCD_BAR_WORDS 3456
#define XB_SPIN_CAP (1u << 18)

__device__ __forceinline__ unsigned xb_ld(unsigned* p)              { return __hip_atomic_load(p, __ATOMIC_RELAXED, __HIP_MEMORY_SCOPE_AGENT); }
__device__ __forceinline__ unsigned xb_add(unsigned* p, unsigned v) { return __hip_atomic_fetch_add(p, v, __ATOMIC_RELAXED, __HIP_MEMORY_SCOPE_AGENT); }
__device__ __forceinline__ unsigned xb_xcc_id() { return (unsigned)__builtin_amdgcn_s_getreg((3 << 11) | 20) & 0xFu; }
#define XB_SPIN(cond, bar) do { unsigned _sp = 0; while (cond) { __builtin_amdgcn_s_sleep(1); \
    if ((++_sp & 255u) == 0u) { if (xb_ld(&(bar)[XB_TMO])) break; if (_sp > XB_SPIN_CAP) { atomicAdd(&(bar)[XB_TMO], 1u); break; } } } } while (0)

struct XcdBarrier {
    unsigned* bar; unsigned x;
    volatile LAS unsigned* st;
};

__device__ __forceinline__ XcdBarrier xcd_barrier_post(unsigned* bar, volatile LAS unsigned* st) {
    XcdBarrier b; b.bar = bar; b.x = xb_xcc_id(); b.st = st;
    if (threadIdx.x == 0) (void)xb_add(&bar[XB_XCNT(b.x)], 1u);
    return b;
}
__device__ __forceinline__ void xcd_barrier_complete(unsigned* bar, unsigned x, unsigned& nloc, unsigned& nx) {
    const unsigned G = gridDim.x * gridDim.y * gridDim.z;
    unsigned sum, cnt, mine, sp = 0u;
    for (;;) {
        sum = 0u; cnt = 0u; mine = 0u;
#pragma unroll
        for (unsigned j = 0; j < 16; ++j) { const unsigned c = xb_ld(&bar[XB_XCNT(j)]); sum += c; cnt += (c > 0u) ? 1u : 0u; mine = (j == x) ? c : mine; }
        if (sum == G) break;
        __builtin_amdgcn_s_sleep(1);
        if ((++sp & 255u) == 0u) { if (xb_ld(&bar[XB_TMO])) break; if (sp > XB_SPIN_CAP) { atomicAdd(&bar[XB_TMO], 1u); break; } }
    }
    nloc = mine > 0u ? mine : 1u; nx = cnt > 0u ? cnt : 1u;
}

__device__ __forceinline__ void xcd_barrier(const XcdBarrier& b) {
    asm volatile("s_waitcnt vmcnt(0)" ::: "memory");
    __syncthreads();
    if (threadIdx.x == 0) {
        unsigned* bar = b.bar;
        __builtin_amdgcn_s_waitcnt(0);
        unsigned nloc = b.st[0], nx = b.st[1];
        if (nloc == 0u) { xcd_barrier_complete(bar, b.x, nloc, nx); b.st[0] = nloc; b.st[1] = nx; }
        const unsigned old = xb_add(&bar[XB_XSUB(b.x)], 1u);
        const unsigned gen = old / nloc;
        if (old + 1u == (gen + 1u) * nloc) {
            __builtin_amdgcn_fence(__ATOMIC_RELEASE, "agent");
            asm volatile("s_waitcnt vmcnt(0)" ::: "memory");
            const unsigned og = xb_add(&bar[XB_TOP], 1u);
            const unsigned tg = og / nx;
            if (og + 1u == (tg + 1u) * nx) xb_add(&bar[XB_TOPGEN], 1u);
            else XB_SPIN(xb_ld(&bar[XB_TOPGEN]) == tg, bar);
            __builtin_amdgcn_fence(__ATOMIC_ACQUIRE, "agent");
            xb_add(&bar[XB_XGEN(b.x)], 1u);
            asm volatile("s_waitcnt vmcnt(0)" ::: "memory");
        } else {
            XB_SPIN(xb_ld(&bar[XB_XGEN(b.x)]) == gen, bar);
            __builtin_amdgcn_fence(__ATOMIC_ACQUIRE, "agent");
            asm volatile("s_waitcnt vmcnt(0)" ::: "memory");
        }
    }
    __syncthreads();
}


#ifndef REP_CONV
#define REP_CONV 1
#endif
#ifndef REP_GMLP
#define REP_GMLP 1
#endif
#ifndef REP_PRO
#define REP_PRO 1
#endif
#ifndef REP_RP
#define REP_RP 1
#endif
#ifndef REP_GU
#define REP_GU 1
#endif
#ifndef REP_DN
#define REP_DN 1
#endif
#ifndef REP_WIN
#define REP_WIN 1
#endif
#ifndef REP_MIX2
#define REP_MIX2 1
#endif
#define GEMM_CALL(EpiT, E, Aptr, Bptr, Mv, Nv, Kv) do { pg8::Gemm g_{(Aptr), (Bptr), (Mv), (Nv), (Kv)}; pg8::StaticOrder S_; S_.init((Mv), (Nv), G, (int)blockIdx.x); \
        int l_o_ = lane_id(); asm volatile("" : "+v"(l_o_)); pg8::gemm_phase<EpiT, pg8::StaticOrder, true, true>(lds, g_, S_, (E), wave * 64 + l_o_); __syncthreads(); } while (0)

__global__ void __launch_bounds__(NTHR, 2) mk_fwd(Args a) {
    extern __shared__ __attribute__((aligned(16))) unsigned char lds_raw[];
    LAS unsigned char* lds = (LAS unsigned char*)lds_raw;
    cg::grid_group grid = cg::this_grid();
    const int wave = __builtin_amdgcn_readfirstlane((int)threadIdx.x >> 6);
    const int G = gridDim.x, bx = blockIdx.x, vcu = (G % 8 == 0) ? (bx % 8) * (G / 8) + bx / 8 : bx;
    const int gw = vcu * NWAVES + wave, NGW = G * NWAVES, gthreads = G * NTHR;
    unsigned char* const ws_k = a.ws;
#define rope ((float*)(ws + WS_ROPE))
#define PQ ((float*)(ws + WS_PQ))
#define PKV ((float*)(ws + WS_PKV))
#define PV ((float*)(ws + WS_PV))
#define RSv ((float*)(ws + WS_RS))
#define XN ((bf16_t*)(ws + WS_XN))
#define ACT ((bf16_t*)(ws + WS_ACT))
#define ZC ((bf16_t*)(ws + WS_ZC))
#define CQ ((bf16_t*)(ws + WS_CQ))
#define Ub ((bf16_t*)(ws + WS_U))
#define Vb ((bf16_t*)(ws + WS_V))
#define CKV ((bf16_t*)(ws + WS_CKV))
#define KR ((bf16_t*)(ws + WS_KR))
#define Qb ((bf16_t*)(ws + WS_Q))
#define KVb ((bf16_t*)(ws + WS_KV))
#define Yb ((bf16_t*)(ws + WS_Y))
#define Hb ((bf16_t*)(ws + WS_H))
    float* X = a.out;
    volatile LAS unsigned* misc = (volatile LAS unsigned*)(lds + LDS_BYTES - 64);
    if (threadIdx.x < 2) misc[threadIdx.x] = 0u;
    if (bx == 0) { for (int i = threadIdx.x; i < XCD_BAR_WORDS; i += NTHR) ((unsigned*)(a.ws + 65536))[i] = 0u; }
    XcdBarrier xbar; xbar.bar = (unsigned*)(a.ws + 65536); xbar.x = 0; xbar.st = misc;
    int ph = 0;
    const int lo = a.ph_lo, hi = a.ph_hi;
#define RUN (ph >= lo && ph < hi)
#define OPAQUE_IDS unsigned long long wsv_ = (unsigned long long)ws_k; asm volatile("" : "+s"(wsv_)); unsigned char* ws = (unsigned char*)(__attribute__((address_space(1))) unsigned char*)wsv_; int lane_o_ = lane_id(); asm volatile("" : "+v"(lane_o_)); const int tid = wave * 64 + lane_o_; const int lane = tid & 63, gtid = bx * NTHR + tid; (void)lane; (void)gtid;
#define SEAM do { if (ph >= lo && ph + 1 < hi) { if (ph == 0) { grid.sync(); xbar = xcd_barrier_post((unsigned*)(a.ws + 65536), misc); } else xcd_barrier(xbar); } ++ph; } while (0)

    if (RUN) { OPAQUE_IDS
#ifndef NO_PRO
        _Pragma("unroll 1") for (int rr_ = 0; rr_ < REP_PRO; ++rr_) prologue_weights(a, ws, lds, gw, NGW, wave, lane);
#endif
        rope_table(rope, gtid, gthreads);
        row_pass(a.in[0], nullptr, nullptr, 0.f, nullptr, nullptr, XN, RSv, gw, NGW, lane);
    }
    SEAM;

#pragma unroll 1
    for (int sb = 0; sb < 6; ++sb) {
        const int l = sb / 3, kind = sb % 3;
        if (kind != 1) {
            #ifndef NO_GU
            _Pragma("unroll 1") for (int rep_ = 0; rep_ < REP_GU; ++rep_)
            if (RUN) { OPAQUE_IDS EpiSwiGLU E{ACT, RSv}; GEMM_CALL(EpiSwiGLU, E, XN, wptr(ws, l, kind == 0 ? OFF_GU1 : OFF_GU2), T_TOK, NGU, DM); }
#endif
            SEAM;
            #ifndef NO_DN
            _Pragma("unroll 1") for (int rep_ = 0; rep_ < REP_DN; ++rep_)
#ifdef PROBE_SPLIT_DN
            _Pragma("unroll 1") for (int half_ = 0; half_ < 2; ++half_) { OPAQUE_IDS EpiPlain E{Hb, DM};
                { pg8::Gemm g_{ACT, wptr(ws, l, kind == 0 ? OFF_DN1 : OFF_DN2), T_TOK, DM, DFF}; pg8::StaticOrder S_; S_.init(T_TOK, DM, G, (int)blockIdx.x); S_.i0 = 2 * half_; S_.iend = 2 * half_ + 2;
                  int l_o_ = lane_id(); asm volatile("" : "+v"(l_o_)); pg8::gemm_phase<EpiPlain, pg8::StaticOrder, true, true>(lds, g_, S_, E, wave * 64 + l_o_); __syncthreads(); }
                if (half_ == 0) xcd_barrier(xbar); }
#else
            if (RUN) { OPAQUE_IDS EpiPlain E{Hb, DM}; GEMM_CALL(EpiPlain, E, ACT, wptr(ws, l, kind == 0 ? OFF_DN1 : OFF_DN2), T_TOK, DM, DFF); }
#endif
#endif
            SEAM;
            if (RUN) { OPAQUE_IDS
                const float* gpost = a.in[kind == 0 ? 4 : 21] + l * DM;
                if (sb == 0) { _Pragma("unroll 1") for (int rr_ = 0; rr_ < REP_RP; ++rr_) row_pass(a.in[0], nullptr, Hb, 0.5f, gpost, nullptr, XN, RSv, gw, NGW, lane); }
                else if (sb == 5) row_pass(nullptr, XN, Hb, 0.5f, gpost, X, nullptr, RSv, gw, NGW, lane);
                else row_pass(nullptr, XN, Hb, 0.5f, gpost, nullptr, XN, RSv, gw, NGW, lane);
            }
            SEAM;
        } else {
            #ifndef NO_WIN
            _Pragma("unroll 1") for (int rep_ = 0; rep_ < REP_WIN; ++rep_)
            if (RUN) { OPAQUE_IDS EpiWin E{ZC, CQ, Ub, Vb, CKV, KR, PQ, PV, PKV, rope, RSv}; GEMM_CALL(EpiWin, E, XN, wptr(ws, l, OFF_IN), T_TOK, NIN_P, DM); }
#endif
            SEAM;
            _Pragma("unroll 1") for (int rep_ = 0; rep_ < REP_MIX2; ++rep_)
            if (RUN) { OPAQUE_IDS
#ifndef NO_UQ
                { EpiUq E{Qb, PQ, rope}; GEMM_CALL(EpiUq, E, CQ, wptr(ws, l, OFF_UQ), T_TOK, NQ, 256); }
#endif
#ifndef NO_UKV
                { EpiUkv E{KVb, PKV}; GEMM_CALL(EpiUkv, E, CKV, wptr(ws, l, OFF_UKV), T_TOK, NKV, 128); }
#endif
#ifndef NO_CONV
                _Pragma("unroll 1") for (int rc_ = 0; rc_ < REP_CONV; ++rc_) { OPAQUE_IDS conv_phase(ZC, a.in[7] + l * 768, a.in[8] + l * 256, Yb, gtid, gthreads); }
#endif
#ifndef NO_GMLP
                _Pragma("unroll 1") for (int rg_ = 0; rg_ < REP_GMLP; ++rg_) { OPAQUE_IDS gmlp_phase(lds, Ub, Vb, PV, a.in[13] + l * 256, wptr(ws, l, OFF_GWS), a.in[15] + l * 512, Yb, gw, NGW, wave, lane); }
#endif
            }
            SEAM;
#ifndef NO_ATTN
            if (RUN) { OPAQUE_IDS attn_phase(lds, Qb, KVb, KR, Yb, vcu, G, tid); }
#ifdef PROBE_DUP_ATTN
            if (RUN) { __syncthreads(); OPAQUE_IDS attn_phase(lds, Qb, KVb, KR, Yb, vcu, G, tid); }
#endif
#endif
            SEAM;
#ifndef NO_OUT
            _Pragma("unroll 1") for (int rep_ = 0; rep_ < REP_WIN; ++rep_)
            if (RUN) { OPAQUE_IDS EpiPlain E{Hb, DM}; GEMM_CALL(EpiPlain, E, Yb, wptr(ws, l, OFF_OUT), T_TOK, DM, DM); }
#endif
            SEAM;
            if (RUN) { OPAQUE_IDS row_pass(nullptr, XN, Hb, 1.0f, a.in[17] + l * DM, nullptr, XN, RSv, gw, NGW, lane); }
            SEAM;
        }
    }
}
constexpr int N_PHASES = 1 + 2 * (3 + 5 + 3);

#ifndef MK_SPLIT
#define MK_SPLIT 0
#endif
extern "C" void kernel_launch(void* const* d_in, const int* in_sizes, int n_in, void* d_out, int out_size, void* d_ws, size_t ws_size, hipStream_t stream) {
    static int grid = 0;
    if (grid == 0) {
        if (n_in != 22 || out_size != T_TOK * DM || ws_size < WS_END) { fprintf(stderr, "kernel_launch: unexpected shapes n_in %d out %d ws %zu\n", n_in, out_size, ws_size); grid = -1; return; }
        int dev = 0, cus = 0, per_cu = 0;
        (void)hipGetDevice(&dev); (void)hipDeviceGetAttribute(&cus, hipDeviceAttributeMultiprocessorCount, dev);
        if (hipFuncSetAttribute((const void*)mk_fwd, hipFuncAttributeMaxDynamicSharedMemorySize, LDS_BYTES) != hipSuccess) { fprintf(stderr, "kernel_launch: hipFuncSetAttribute failed\n"); grid = -1; return; }
        if (hipOccupancyMaxActiveBlocksPerMultiprocessor(&per_cu, (const void*)mk_fwd, NTHR, LDS_BYTES) != hipSuccess || per_cu < 1) { fprintf(stderr, "kernel_launch: occupancy query says %d\n", per_cu); per_cu = 1; }
        (void)hipGetLastError();
        grid = cus * per_cu;
        if (grid > cus) grid = cus;
    }
    if (grid < 0) return;
    Args a{};
    for (int i = 0; i < 22; ++i) a.in[i] = (const float*)d_in[i];
    a.out = (float*)d_out; a.ws = (unsigned char*)d_ws;
#if MK_SPLIT
    for (int p = 0; p < N_PHASES; ++p) { a.ph_lo = p; a.ph_hi = p + 1; hipLaunchKernelGGL(mk_fwd, dim3(grid), dim3(NTHR), LDS_BYTES, stream, a); }
#else
    a.ph_lo = 0; a.ph_hi = N_PHASES;
    void* args[] = {&a};
    hipError_t e = hipLaunchCooperativeKernel((const void*)mk_fwd, dim3(grid), dim3(NTHR), args, LDS_BYTES, stream);
    if (e != hipSuccess) fprintf(stderr, "cooperative launch failed: %s (grid %d)\n", hipGetErrorString(e), grid);
#endif
}
```

```cpp
#include <hip/hip_runtime.h>
#include <hip/hip_cooperative_groups.h>
#include <cstdio>
#include <cstdint>
namespace cg = cooperative_groups;
namespace pg8 {
#define PG8_LAS __attribute__((address_space(3)))
typedef unsigned short bf16_t;
typedef short bf16x8 __attribute__((ext_vector_type(8)));
typedef float f32x4 __attribute__((ext_vector_type(4)));
typedef unsigned u32x4 __attribute__((ext_vector_type(4)));
constexpr int BM = 256, BK = 64, HALF = 128, HTB = HALF * BK * 2  , STAGE_BYTES = 8 * HTB, NXCD = 8, WGM = 8;

__host__ __device__ __forceinline__ int lds_byte(int r, int c) { const int st = (r >> 4) * 2 + (c >> 5), rr = r & 15, cc = c & 31, ob = rr * 64 + cc * 2; return st * 1024 + (ob ^ (((ob >> 9) & 1) << 5)); }
__host__ __device__ __forceinline__ void stage_rc(int b, int& R, int& C) { const int st = b / 1024, sb = b % 1024, swz = sb ^ (((sb >> 9) & 1) << 5); R = (st >> 1) * 16 + swz / 64; C = (st & 1) * 32 + (swz % 64) / 2; }
__host__ __device__ __forceinline__ int perm32(int rho) { const int n = rho >> 4, i = rho & 15; return 8 * (i >> 2) + 4 * n + (i & 3); }

struct Unit { int pm, pn; };
struct Gemm { const bf16_t* A; const bf16_t* Bt; int M, N, K; };

struct StaticOrder {
    int nM, nN, nwg, G, c, i0, iend;
    __host__ __device__ void init(int M, int N, int G_, int c_) { nM = M / BM; nN = N / BM; nwg = nM * nN; G = G_; c = c_; i0 = 0; iend = 1 << 30; }
    __host__ __device__ bool next(int i, Unit& u) const {
        const long L = (long)(i + i0) * G + c; if (i + i0 >= iend || L >= nwg) return false;
        int wgid = (int)L; { const int q = nwg / NXCD, r = nwg % NXCD, xcd = wgid % NXCD, off = wgid / NXCD; wgid = (xcd < r ? xcd * (q + 1) : r * (q + 1) + (xcd - r) * q) + off; }
        const int nig = WGM * nN, gid = wgid / nig, fm = gid * WGM, gsz = (nM - fm) < WGM ? (nM - fm) : WGM;
        u.pm = fm + ((wgid % nig) % gsz); u.pn = (wgid % nig) / gsz; return true;
    }
    __device__ __forceinline__ void a_ready(const Unit&) const {}
    __device__ __forceinline__ void done(const Unit&) const {}
};

__device__ __forceinline__ unsigned cvt_pk_bf16(float lo, float hi) { unsigned r; asm volatile("v_cvt_pk_bf16_f32 %0, %1, %2" : "=v"(r) : "v"(lo), "v"(hi)); return r; }
typedef float f32x2 __attribute__((ext_vector_type(2)));
__device__ __forceinline__ f32x2 gelu_pk(f32x2 v) {
    const f32x2 av = __builtin_elementwise_abs(v), d = av * 0.2316418882f + 1.0f;
    f32x2 t; t.x = __builtin_amdgcn_rcpf(d.x); t.y = __builtin_amdgcn_rcpf(d.y);
    f32x2 q = t * 0.5307027145f + (-0.7265760135f); q = q * t + 0.7107068705f; q = q * t + (-0.142248368f); q = q * t + 0.127414796f; q = q * t;
    const f32x2 s = (v * v) * (-0.72134752044f);
    f32x2 e; e.x = __builtin_amdgcn_exp2f(s.x); e.y = __builtin_amdgcn_exp2f(s.y);
    const f32x2 m = v * (q * e), r = v - m;
    f32x2 o; o.x = v.x < 0.f ? m.x : r.x; o.y = v.y < 0.f ? m.y : r.y; return o;
}
template <class Epi, class Sched, bool ALIGN_EPI = false, bool SP2 = false>
__device__ __forceinline__ void gemm_phase(PG8_LAS unsigned char* lds, const Gemm g, const Sched& S, const Epi& E, const int tid_in) {
    const int tid = tid_in, wid = __builtin_amdgcn_readfirstlane(tid >> 6), lane = tid & 63, wr = wid >> 2, wc = wid & 3, fr = lane & 15, fq = lane >> 4;
    const int K = g.K, nt = K / BK;
    unsigned voffA[2], voffB[2];
#pragma unroll
    for (int i = 0; i < 2; ++i) { int R, C; stage_rc(tid * 16 + i * 8192, R, C); const int Rb = Epi::PERM ? ((R & ~31) + perm32(R & 31)) : R;
        voffA[i] = (unsigned)(R * K + C) * 2u; voffB[i] = (unsigned)(Rb * K + C) * 2u; }
    const size_t kstep = (size_t)(BK * 2);
    const size_t hstep = (size_t)HALF * K * 2;
    const size_t tstep = 2 * hstep;
    const unsigned ldsw = (unsigned)wid * 1024u;
    const int aoff = lds_byte(wr * 64 + fr, fq * 8), boff = lds_byte(wc * 32 + fr, fq * 8);
#define PG8_SA(b, h) (((b) * 2 + (h)) * HTB)
#define PG8_SB(b, h) ((4 + (b) * 2 + (h)) * HTB)
#define PG8_STAGE(bufoff, gbase, voff) do { _Pragma("unroll") for (int _i = 0; _i < 2; ++_i) \
        __builtin_amdgcn_global_load_lds((const unsigned*)((const char*)(gbase) + (voff)[_i]), (PG8_LAS unsigned*)(lds + (bufoff) + ldsw + _i * 8192), 16, 0, 0); } while (0)
#define PG8_LDA(dst, b, h) do { _Pragma("unroll") for (int m = 0; m < 4; ++m) _Pragma("unroll") for (int k = 0; k < 2; ++k) dst[m][k] = *(const PG8_LAS bf16x8*)(lds + PG8_SA(b, h) + aoff + m * 2048 + k * 1024); } while (0)
#define PG8_LDB(dst, b, h) do { _Pragma("unroll") for (int n = 0; n < 2; ++n) _Pragma("unroll") for (int k = 0; k < 2; ++k) dst[n][k] = *(const PG8_LAS bf16x8*)(lds + PG8_SB(b, h) + boff + n * 2048 + k * 1024); } while (0)
#define PG8_MMA(ai, bj, At, Bt) do { __builtin_amdgcn_s_setprio(1); _Pragma("unroll") for (int m = 0; m < 4; ++m) _Pragma("unroll") for (int n = 0; n < 2; ++n) _Pragma("unroll") for (int k = 0; k < 2; ++k) \
        acc[ai][bj][m][n] = __builtin_amdgcn_mfma_f32_16x16x32_bf16(Bt[n][k], At[m][k], acc[ai][bj][m][n], 0, 0, 0); __builtin_amdgcn_s_setprio(0); } while (0)
#define PG8_WAIT_V(n) asm volatile("s_waitcnt vmcnt(" #n ")" ::: "memory")
#define PG8_WAIT_L(n) asm volatile("s_waitcnt lgkmcnt(" #n ")" ::: "memory")
#define PG8_BAR __builtin_amdgcn_s_barrier()
#define PG8_SCHED __builtin_amdgcn_sched_barrier(0)
    Unit cur, nxt; int ui = 0;
    if (!S.next(0, cur)) return;
    f32x4 acc[2][2][4][2];
#pragma unroll
    for (int a = 0; a < 2; ++a)
#pragma unroll
        for (int b = 0; b < 2; ++b)
#pragma unroll
            for (int m = 0; m < 4; ++m)
#pragma unroll
                for (int n = 0; n < 2; ++n) acc[a][b][m][n] = (f32x4){0.f, 0.f, 0.f, 0.f};
    bf16x8 At[4][2], B0[2][2], B1[2][2];
    const char* cA = (const char*)g.A + (size_t)cur.pm * tstep; const char* cB = (const char*)g.Bt + (size_t)cur.pn * tstep;
    S.a_ready(cur);
    if constexpr (SP2) {
        PG8_STAGE(PG8_SB(0, 0), cB, voffB); PG8_STAGE(PG8_SB(0, 1), cB + hstep, voffB); PG8_STAGE(PG8_SA(0, 0), cA, voffA); PG8_STAGE(PG8_SA(0, 1), cA + hstep, voffA);
        if (wr == 1) PG8_BAR;
        PG8_WAIT_V(2); PG8_BAR;
        PG8_STAGE(PG8_SB(1, 0), cB + kstep, voffB); PG8_STAGE(PG8_SA(1, 0), cA + kstep, voffA); PG8_STAGE(PG8_SB(1, 1), cB + hstep + kstep, voffB);
        PG8_WAIT_V(6); PG8_BAR;
    } else {
        PG8_STAGE(PG8_SB(0, 0), cB, voffB); PG8_STAGE(PG8_SA(0, 0), cA, voffA); PG8_STAGE(PG8_SB(0, 1), cB + hstep, voffB); PG8_STAGE(PG8_SA(0, 1), cA + hstep, voffA);
        if (wr == 1) PG8_BAR;
        PG8_WAIT_V(4); PG8_BAR;
        PG8_STAGE(PG8_SB(1, 0), cB + kstep, voffB); PG8_STAGE(PG8_SA(1, 0), cA + kstep, voffA); PG8_STAGE(PG8_SB(1, 1), cB + hstep + kstep, voffB);
        PG8_WAIT_V(6); PG8_BAR;
    }
    for (;;) {
        const bool has_next = S.next(ui + 1, nxt);
        const char* nA = has_next ? (const char*)g.A + (size_t)nxt.pm * tstep : cA; const char* nB = has_next ? (const char*)g.Bt + (size_t)nxt.pn * tstep : cB;
        for (int t = 0; t < nt; t += 2) {
            const bool last = (t == nt - 2);
            const char* a1 = cA + (size_t)(t + 1) * kstep;
            const char* a2 = last ? nA : cA + (size_t)(t + 2) * kstep; const char* b2 = last ? nB : cB + (size_t)(t + 2) * kstep;
            const char* a3 = a2 + kstep; const char* b3 = b2 + kstep;
            if (last && has_next) S.a_ready(nxt);
            if constexpr (SP2) {
            PG8_LDB(B0, 0, 0); PG8_LDB(B1, 0, 1); PG8_SCHED; PG8_LDA(At, 0, 0); PG8_STAGE(PG8_SA(1, 1), a1 + hstep, voffA);
            PG8_WAIT_V(8); PG8_WAIT_L(0); PG8_BAR; PG8_MMA(0, 0, At, B0); PG8_MMA(0, 1, At, B1); PG8_BAR; PG8_SCHED;
            PG8_LDA(At, 0, 1); PG8_STAGE(PG8_SB(0, 0), b2, voffB); PG8_STAGE(PG8_SB(0, 1), b2 + hstep, voffB); PG8_STAGE(PG8_SA(0, 0), a2, voffA);
            PG8_WAIT_V(8); PG8_WAIT_L(0); PG8_BAR; PG8_MMA(1, 0, At, B0); PG8_MMA(1, 1, At, B1); PG8_BAR; PG8_SCHED;
            PG8_LDB(B0, 1, 0); PG8_LDB(B1, 1, 1); PG8_SCHED; PG8_LDA(At, 1, 0); PG8_STAGE(PG8_SA(0, 1), a2 + hstep, voffA);
            PG8_WAIT_V(8); PG8_WAIT_L(0); PG8_BAR; PG8_MMA(0, 0, At, B0); PG8_MMA(0, 1, At, B1); PG8_BAR; PG8_SCHED;
            PG8_LDA(At, 1, 1); PG8_STAGE(PG8_SB(1, 0), b3, voffB); PG8_STAGE(PG8_SB(1, 1), b3 + hstep, voffB); PG8_STAGE(PG8_SA(1, 0), a3, voffA);
            PG8_WAIT_V(8); PG8_WAIT_L(0); PG8_BAR; PG8_MMA(1, 0, At, B0); PG8_MMA(1, 1, At, B1); PG8_BAR; PG8_SCHED;
            } else {
            PG8_LDB(B0, 0, 0); PG8_SCHED; PG8_LDA(At, 0, 0); PG8_STAGE(PG8_SA(1, 1), a1 + hstep, voffA);
            PG8_WAIT_L(8); PG8_BAR; PG8_WAIT_L(0); PG8_MMA(0, 0, At, B0); PG8_BAR; PG8_SCHED;
            PG8_LDB(B1, 0, 1); PG8_STAGE(PG8_SB(0, 0), b2, voffB);
            PG8_BAR; PG8_WAIT_L(0); PG8_MMA(0, 1, At, B1); PG8_BAR;
            PG8_LDA(At, 0, 1); PG8_STAGE(PG8_SA(0, 0), a2, voffA);
            PG8_BAR; PG8_WAIT_L(0); PG8_MMA(1, 0, At, B0); PG8_BAR; PG8_SCHED;
            PG8_STAGE(PG8_SB(0, 1), b2 + hstep, voffB);
            PG8_WAIT_V(6); PG8_BAR; PG8_MMA(1, 1, At, B1); PG8_BAR;
            PG8_LDB(B0, 1, 0); PG8_SCHED; PG8_LDA(At, 1, 0); PG8_STAGE(PG8_SA(0, 1), a2 + hstep, voffA);
            PG8_WAIT_L(8); PG8_BAR; PG8_WAIT_L(0); PG8_MMA(0, 0, At, B0); PG8_BAR; PG8_SCHED;
            PG8_LDB(B1, 1, 1); PG8_STAGE(PG8_SB(1, 0), b3, voffB);
            PG8_BAR; PG8_WAIT_L(0); PG8_MMA(0, 1, At, B1); PG8_BAR;
            PG8_LDA(At, 1, 1); PG8_STAGE(PG8_SA(1, 0), a3, voffA);
            PG8_BAR; PG8_WAIT_L(0); PG8_MMA(1, 0, At, B0); PG8_BAR; PG8_SCHED;
            PG8_STAGE(PG8_SB(1, 1), b3 + hstep, voffB);
            PG8_WAIT_V(6); PG8_BAR; PG8_MMA(1, 1, At, B1); PG8_BAR;
            }
        }
        if constexpr (ALIGN_EPI) { if (wr == 0) PG8_BAR; }
        if constexpr (!Epi::AFTER_DRAIN) { E(acc, cur, wr, wc, fr, fq); S.done(cur); }
        if (!has_next) break;
#pragma unroll
        for (int a = 0; a < 2; ++a)
#pragma unroll
            for (int b = 0; b < 2; ++b)
#pragma unroll
                for (int m = 0; m < 4; ++m)
#pragma unroll
                    for (int n = 0; n < 2; ++n) acc[a][b][m][n] = (f32x4){0.f, 0.f, 0.f, 0.f};
        cur = nxt; cA = nA; cB = nB; ++ui;
        if constexpr (ALIGN_EPI) { if (wr == 1) PG8_BAR; }
    }
    PG8_WAIT_V(0);
    if constexpr (!ALIGN_EPI) { if (wr == 0) PG8_BAR; }
    PG8_BAR;
    if constexpr (Epi::AFTER_DRAIN) { E.fused(acc, cur, wr, wc, fr, fq, lds, wid, lane); S.done(cur); }
#undef PG8_SA
#undef PG8_SB
#undef PG8_STAGE
#undef PG8_LDA
#undef PG8_LDB
#undef PG8_MMA
#undef PG8_WAIT_V
#undef PG8_WAIT_L
#undef PG8_BAR
#undef PG8_SCHED
}
}

#define LAS __attribute__((address_space(3)))
using pg8::f32x4; using pg8::bf16_t; using pg8::Unit; using pg8::u32x4; using pg8::f32x2; using pg8::bf16x8;
typedef float f32x16 __attribute__((ext_vector_type(16)));
typedef short s16x4 __attribute__((ext_vector_type(4)));
typedef unsigned u32x2 __attribute__((ext_vector_type(2)));
typedef __bf16 bf16x2_t __attribute__((ext_vector_type(2)));

constexpr int T_TOK = 65536, SEQ = 2048, DM = 1024, DFF = 2816, NGU = 5632, NIN_P = 1792, NQ = 768, NKV = 1024;
constexpr float EPS = 1e-6f;
constexpr int NWAVES = 8, NTHR = 512;
constexpr int LDS_BYTES = 147456;
constexpr float QSCALE = 0.10206207261596575f * 1.4426950408889634f;

constexpr size_t MiB = 1u << 20;
constexpr size_t WS_ROPE = 1 * MiB;
constexpr size_t WS_PQ = 2 * MiB, WS_PKV = 3 * MiB, WS_PV = 4 * MiB, WS_RS = 5 * MiB;
constexpr size_t WS_W = 8 * MiB, WS_WL = 42 * MiB;
constexpr size_t WS_XN = 96 * MiB;
constexpr size_t WS_ACT = 224 * MiB;
constexpr size_t WS_ZC = 224 * MiB, WS_CQ = 320 * MiB, WS_U = 352 * MiB, WS_V = 384 * MiB, WS_CKV = 416 * MiB, WS_KR = 432 * MiB, WS_Q = 448 * MiB;
constexpr size_t WS_KV = 576 * MiB, WS_Y = 704 * MiB, WS_H = 832 * MiB, WS_END = 960 * MiB;

__device__ __forceinline__ unsigned cvtpk(float lo, float hi) { f32x2 v = {lo, hi}; bf16x2_t b = __builtin_convertvector(v, bf16x2_t); return __builtin_bit_cast(unsigned, b); }
__device__ __forceinline__ u32x4 pack8(f32x4 v0, f32x4 v1) { u32x4 w; w.x = cvtpk(v0[0], v0[1]); w.y = cvtpk(v0[2], v0[3]); w.z = cvtpk(v1[0], v1[1]); w.w = cvtpk(v1[2], v1[3]); return w; }
__device__ __forceinline__ unsigned short f2bf(float f) { unsigned u = __builtin_bit_cast(unsigned, f); return (unsigned short)((u + 0x7fffu + ((u >> 16) & 1u)) >> 16); }
__device__ __forceinline__ float bf2f(unsigned short b) { return __builtin_bit_cast(float, (unsigned)b << 16); }
__device__ __forceinline__ float bflo(unsigned w) { return __builtin_bit_cast(float, w << 16); }
__device__ __forceinline__ float bfhi(unsigned w) { return __builtin_bit_cast(float, w & 0xffff0000u); }
__device__ __forceinline__ float silu_mul(float g, float u) { return g * __builtin_amdgcn_rcpf(1.0f + __builtin_amdgcn_exp2f(-1.4426950408889634f * g)) * u; }
__device__ __forceinline__ f32x4 gelu4(f32x4 v) { f32x2 a = pg8::gelu_pk((f32x2){v[0], v[1]}), b = pg8::gelu_pk((f32x2){v[2], v[3]}); return (f32x4){a.x, a.y, b.x, b.y}; }
__device__ __forceinline__ float sumsq4(f32x4 v) { return (v[0] * v[0] + v[1] * v[1]) + (v[2] * v[2] + v[3] * v[3]); }
__device__ __forceinline__ float shflx(float v, int o, int lane) { return __builtin_bit_cast(float, __builtin_amdgcn_ds_bpermute((lane ^ o) << 2, __builtin_bit_cast(int, v))); }
__device__ __forceinline__ float wave_sum(float v, int lane) {
#pragma unroll
    for (int o = 1; o < 64; o <<= 1) v += shflx(v, o, lane);
    return v;
}

struct EpiPlain {
    static constexpr bool PERM = true, AFTER_DRAIN = false;
    bf16_t* O; int ldc;
    __device__ __forceinline__ void operator()(const f32x4 (&acc)[2][2][4][2], const Unit& u, int wr, int wc, int fr, int fq) const {
        const int row0 = u.pm * 256 + wr * 64 + fr, col0 = u.pn * 256 + wc * 32 + 8 * fq;
#pragma unroll
        for (int ai = 0; ai < 2; ++ai)
#pragma unroll
            for (int m = 0; m < 4; ++m) { bf16_t* rowp = O + (size_t)(row0 + ai * 128 + m * 16) * ldc + col0;
#pragma unroll
                for (int bj = 0; bj < 2; ++bj) *(u32x4*)(rowp + bj * 128) = pack8(acc[ai][bj][m][0], acc[ai][bj][m][1]); }
    }
};
struct EpiSwiGLU {
    static constexpr bool PERM = true, AFTER_DRAIN = false;
    bf16_t* O; const float* RS;
    __device__ __forceinline__ void operator()(const f32x4 (&acc)[2][2][4][2], const Unit& u, int wr, int wc, int fr, int fq) const {
        const int row0 = u.pm * 256 + wr * 64 + fr, col0 = u.pn * 128 + wc * 32 + 8 * fq;
#pragma unroll
        for (int ai = 0; ai < 2; ++ai)
#pragma unroll
            for (int m = 0; m < 4; ++m) {
                const f32x4 g0 = acc[ai][0][m][0], g1 = acc[ai][0][m][1], u0 = acc[ai][1][m][0], u1 = acc[ai][1][m][1];
                f32x4 r0, r1;
#pragma unroll
                for (int e = 0; e < 4; ++e) { r0[e] = silu_mul(g0[e], u0[e]); r1[e] = silu_mul(g1[e], u1[e]); }
                *(u32x4*)(O + (size_t)(row0 + ai * 128 + m * 16) * DFF + col0) = pack8(r0, r1);
            }
    }
};
struct EpiWin {
    static constexpr bool PERM = true, AFTER_DRAIN = false;
    bf16_t *ZC, *CQ, *U, *V, *CKV, *KR; float *PQ, *PV, *PKV; const float* rope; const float* RS;
    __device__ __forceinline__ void operator()(const f32x4 (&acc)[2][2][4][2], const Unit& u, int wr, int wc, int fr, int fq) const {
        const int row0 = u.pm * 256 + wr * 64 + fr, cw = wc * 32 + 8 * fq, pn = u.pn;
        if (pn < 3) {
#pragma unroll
            for (int ai = 0; ai < 2; ++ai)
#pragma unroll
                for (int m = 0; m < 4; ++m) { bf16_t* rowp = ZC + (size_t)(row0 + ai * 128 + m * 16) * 768 + pn * 256 + cw;
#pragma unroll
                    for (int bj = 0; bj < 2; ++bj) *(u32x4*)(rowp + bj * 128) = pack8(acc[ai][bj][m][0], acc[ai][bj][m][1]); }
        } else if (pn == 3) {
#pragma unroll
            for (int ai = 0; ai < 2; ++ai)
#pragma unroll
                for (int m = 0; m < 4; ++m) { const int row = row0 + ai * 128 + m * 16; bf16_t* rowp = CQ + (size_t)row * 256 + cw; float ss = 0.f;
#pragma unroll
                    for (int bj = 0; bj < 2; ++bj) { const f32x4 v0 = acc[ai][bj][m][0], v1 = acc[ai][bj][m][1]; ss += sumsq4(v0) + sumsq4(v1); *(u32x4*)(rowp + bj * 128) = pack8(v0, v1); }
                    ss += shflx(ss, 16, fq * 16 + fr); ss += shflx(ss, 32, fq * 16 + fr);
                    if (fq == 0) PQ[(size_t)row * 4 + wc] = ss; }
        } else if (pn == 4) {
#pragma unroll
            for (int ai = 0; ai < 2; ++ai)
#pragma unroll
                for (int m = 0; m < 4; ++m) { bf16_t* rowp = U + (size_t)(row0 + ai * 128 + m * 16) * 256 + cw;
#pragma unroll
                    for (int bj = 0; bj < 2; ++bj) *(u32x4*)(rowp + bj * 128) = pack8(gelu4(acc[ai][bj][m][0]), gelu4(acc[ai][bj][m][1])); }
        } else if (pn == 5) {
#pragma unroll
            for (int ai = 0; ai < 2; ++ai)
#pragma unroll
                for (int m = 0; m < 4; ++m) { const int row = row0 + ai * 128 + m * 16; bf16_t* rowp = V + (size_t)row * 256 + cw; float ss = 0.f;
#pragma unroll
                    for (int bj = 0; bj < 2; ++bj) { const f32x4 v0 = gelu4(acc[ai][bj][m][0]), v1 = gelu4(acc[ai][bj][m][1]); ss += sumsq4(v0) + sumsq4(v1); *(u32x4*)(rowp + bj * 128) = pack8(v0, v1); }
                    ss += shflx(ss, 16, fq * 16 + fr); ss += shflx(ss, 32, fq * 16 + fr);
                    if (fq == 0) PV[(size_t)row * 4 + wc] = ss; }
        } else {
#pragma unroll
            for (int ai = 0; ai < 2; ++ai)
#pragma unroll
                for (int m = 0; m < 4; ++m) { const int row = row0 + ai * 128 + m * 16;
                    const f32x4 v0 = acc[ai][0][m][0], v1 = acc[ai][0][m][1]; float ss = sumsq4(v0) + sumsq4(v1);
                    *(u32x4*)(CKV + (size_t)row * 128 + cw) = pack8(v0, v1);
                    ss += shflx(ss, 16, fq * 16 + fr); ss += shflx(ss, 32, fq * 16 + fr);
                    if (fq == 0) PKV[(size_t)row * 4 + wc] = ss;
                    if (wc == 0) {
                        const f32x4 a = acc[ai][1][m][0], b = acc[ai][1][m][1];
                        const f32x4* rp = (const f32x4*)(rope + ((size_t)(row & (SEQ - 1)) * 16 + 4 * fq) * 2);
                        const f32x4 c0 = rp[0], c1 = rp[1];
                        f32x4 ra, rb;
                        ra[0] = a[0] * c0[0] - a[1] * c0[1]; ra[1] = a[1] * c0[0] + a[0] * c0[1];
                        ra[2] = a[2] * c0[2] - a[3] * c0[3]; ra[3] = a[3] * c0[2] + a[2] * c0[3];
                        rb[0] = b[0] * c1[0] - b[1] * c1[1]; rb[1] = b[1] * c1[0] + b[0] * c1[1];
                        rb[2] = b[2] * c1[2] - b[3] * c1[3]; rb[3] = b[3] * c1[2] + b[2] * c1[3];
                        *(u32x4*)(KR + (size_t)row * 32 + 8 * fq) = pack8(ra, rb);
                    } }
        }
    }
};
struct EpiUq {
    static constexpr bool PERM = true, AFTER_DRAIN = false;
    bf16_t* Q; const float* PQ; const float* rope;
    __device__ __forceinline__ void operator()(const f32x4 (&acc)[2][2][4][2], const Unit& u, int wr, int wc, int fr, int fq) const {
        const int row0 = u.pm * 256 + wr * 64 + fr, col0 = u.pn * 256 + wc * 32 + 8 * fq;
#pragma unroll
        for (int ai = 0; ai < 2; ++ai)
#pragma unroll
            for (int m = 0; m < 4; ++m) { const int row = row0 + ai * 128 + m * 16;
                const f32x4 p = *(const f32x4*)(PQ + (size_t)row * 4);
                const float sc = QSCALE / sqrtf(((p[0] + p[1]) + (p[2] + p[3])) * (1.0f / 256.0f) + EPS);
#pragma unroll
                for (int bj = 0; bj < 2; ++bj) { const int c = col0 + bj * 128, w = c % 96;
                    f32x4 a = acc[ai][bj][m][0] * sc, b = acc[ai][bj][m][1] * sc;
                    if (w >= 64) {
                        const f32x4* rp = (const f32x4*)(rope + ((size_t)(row & (SEQ - 1)) * 16 + ((w - 64) >> 1)) * 2);
                        const f32x4 c0 = rp[0], c1 = rp[1]; f32x4 ra, rb;
                        ra[0] = a[0] * c0[0] - a[1] * c0[1]; ra[1] = a[1] * c0[0] + a[0] * c0[1];
                        ra[2] = a[2] * c0[2] - a[3] * c0[3]; ra[3] = a[3] * c0[2] + a[2] * c0[3];
                        rb[0] = b[0] * c1[0] - b[1] * c1[1]; rb[1] = b[1] * c1[0] + b[0] * c1[1];
                        rb[2] = b[2] * c1[2] - b[3] * c1[3]; rb[3] = b[3] * c1[2] + b[2] * c1[3];
                        a = ra; b = rb;
                    }
                    *(u32x4*)(Q + (size_t)row * NQ + c) = pack8(a, b); } }
    }
};
struct EpiUkv {
    static constexpr bool PERM = true, AFTER_DRAIN = false;
    bf16_t* KV; const float* PKV;
    __device__ __forceinline__ void operator()(const f32x4 (&acc)[2][2][4][2], const Unit& u, int wr, int wc, int fr, int fq) const {
        const int row0 = u.pm * 256 + wr * 64 + fr, col0 = u.pn * 256 + wc * 32 + 8 * fq;
#pragma unroll
        for (int ai = 0; ai < 2; ++ai)
#pragma unroll
            for (int m = 0; m < 4; ++m) { const int row = row0 + ai * 128 + m * 16;
                const f32x4 p = *(const f32x4*)(PKV + (size_t)row * 4);
                const float sc = 1.0f / sqrtf(((p[0] + p[1]) + (p[2] + p[3])) * (1.0f / 128.0f) + EPS);
#pragma unroll
                for (int bj = 0; bj < 2; ++bj) *(u32x4*)(KV + (size_t)row * NKV + col0 + bj * 128) = pack8(acc[ai][bj][m][0] * sc, acc[ai][bj][m][1] * sc); }
    }
};

struct MapId   { __device__ __forceinline__ int operator()(int n) const { return n; } };
struct MapGU   { __device__ __forceinline__ int operator()(int n) const { const int pn = n >> 8, w = n & 255; return w < 128 ? 128 * pn + w : DFF + 128 * pn + (w - 128); } };
struct MapIn   { __device__ __forceinline__ int operator()(int n) const {
    if (n < 1024) return n;
    if (n < 1280) return 1184 + (n - 1024);
    if (n < 1536) return 1440 + (n - 1280);
    if (n < 1664) return 1024 + (n - 1536);
    if (n < 1696) { const int j = n - 1664; return 1152 + (j >> 1) + 16 * (j & 1); }
    return -1; } };
struct MapUq   { __device__ __forceinline__ int operator()(int n) const { const int h = n / 96, w = n % 96; if (w < 64) return n; const int j = w - 64; return h * 96 + 64 + (j >> 1) + 16 * (j & 1); } };

template <class Map>
__device__ __forceinline__ void transpose_item(const float* __restrict__ W, int K, int Nsrc, bf16_t* __restrict__ WT, int Ndst, const float* __restrict__ gk, LAS float* scr, int item, int lane, Map map) {
    const int nblk = Ndst / 32, kb = item / nblk, nb = item % nblk, k0 = 64 * kb, n0 = 32 * nb;
    const int n4 = 4 * (lane & 7), ko = lane >> 3;
    const int s0 = map(n0 + n4), s1 = map(n0 + n4 + 1), s2 = map(n0 + n4 + 2), s3 = map(n0 + n4 + 3);
    const bool contig = (s0 >= 0) && (s1 == s0 + 1) && (s2 == s0 + 2) && (s3 == s0 + 3) && ((s0 & 3) == 0);
#pragma unroll
    for (int i = 0; i < 8; ++i) { const int kk = 8 * i + ko; f32x4 v = {0.f, 0.f, 0.f, 0.f};
        const float* wr = W + (size_t)(k0 + kk) * Nsrc;
        if (contig) v = *(const f32x4*)(wr + s0);
        else { if (s0 >= 0) v[0] = wr[s0]; if (s1 >= 0) v[1] = wr[s1]; if (s2 >= 0) v[2] = wr[s2]; if (s3 >= 0) v[3] = wr[s3]; }
        if (gk) v = v * gk[k0 + kk];
        LAS float* d = scr + kk * 33 + n4; d[0] = v[0]; d[1] = v[1]; d[2] = v[2]; d[3] = v[3]; }
    asm volatile("s_waitcnt lgkmcnt(0)" ::: "memory");
    const int c = lane & 7;
#pragma unroll
    for (int j = 0; j < 4; ++j) { const int n = (lane >> 3) + 8 * j; const LAS float* s = scr + (8 * c) * 33 + n;
        u32x4 o; o.x = cvtpk(s[0 * 33], s[1 * 33]); o.y = cvtpk(s[2 * 33], s[3 * 33]); o.z = cvtpk(s[4 * 33], s[5 * 33]); o.w = cvtpk(s[6 * 33], s[7 * 33]);
        *(u32x4*)(WT + (size_t)(n0 + n) * K + k0 + 8 * c) = o; }
    asm volatile("s_waitcnt lgkmcnt(0)" ::: "memory");
}

struct Args { const float* in[22]; float* out; unsigned char* ws; int ph_lo, ph_hi; };

__device__ __forceinline__ bf16_t* wptr(unsigned char* ws, int layer, size_t off) { return (bf16_t*)(ws + WS_W + (size_t)layer * WS_WL + off); }
constexpr size_t OFF_GU1 = 0, OFF_GU2 = 11 * MiB, OFF_DN1 = 22 * MiB, OFF_DN2 = 28 * MiB, OFF_IN = 34 * MiB, OFF_OUT = 38 * MiB,
                 OFF_UQ = 40 * MiB, OFF_UKV = 40 * MiB + 512 * 1024, OFF_GWS = 41 * MiB;

__device__ __forceinline__ void rope_table(float* rope, int gtid, int gthreads) {
    for (int idx = gtid; idx < SEQ * 16; idx += gthreads) {
        const int pos = idx >> 4, i = idx & 15;
        const float inv = 1.0f / exp2f((float)i * 0.8304820237218406f);
        const float ang = (float)pos * inv;
        const double rev = (double)ang * 0.15915494309189535;
        const float fr = (float)(rev - __builtin_rint(rev));
        rope[2 * idx] = __builtin_amdgcn_cosf(fr); rope[2 * idx + 1] = __builtin_amdgcn_sinf(fr);
    }
}
__device__ __forceinline__ void prologue_weights(const Args& a, unsigned char* ws_, LAS unsigned char* lds, int gw, int NGW, int wave, int lane) {
    LAS float* scr = (LAS float*)(lds + wave * 16384);
    constexpr int I_GU = 16 * (NGU / 32), I_DN = (DFF / 64) * 32, I_IN = 16 * (NIN_P / 32), I_UQ = 4 * (NQ / 32), I_UKV = 2 * 32, I_OUT = 16 * 32;
    constexpr int PER_LAYER = 2 * I_GU + 2 * I_DN + I_IN + I_UQ + I_UKV + I_OUT;
    for (int it = gw; it < 2 * PER_LAYER; it += NGW) {
        const int l = it / PER_LAYER; int r = it % PER_LAYER;
        if (r < I_GU) { transpose_item(a.in[2] + (size_t)l * DM * NGU, DM, NGU, wptr(ws_, l, OFF_GU1), NGU, a.in[1] + l * DM, scr, r, lane, MapGU()); continue; } r -= I_GU;
        if (r < I_GU) { transpose_item(a.in[19] + (size_t)l * DM * NGU, DM, NGU, wptr(ws_, l, OFF_GU2), NGU, a.in[18] + l * DM, scr, r, lane, MapGU()); continue; } r -= I_GU;
        if (r < I_DN) { transpose_item(a.in[3] + (size_t)l * DFF * DM, DFF, DM, wptr(ws_, l, OFF_DN1), DM, nullptr, scr, r, lane, MapId()); continue; } r -= I_DN;
        if (r < I_DN) { transpose_item(a.in[20] + (size_t)l * DFF * DM, DFF, DM, wptr(ws_, l, OFF_DN2), DM, nullptr, scr, r, lane, MapId()); continue; } r -= I_DN;
        if (r < I_IN) { transpose_item(a.in[6] + (size_t)l * DM * 1696, DM, 1696, wptr(ws_, l, OFF_IN), NIN_P, a.in[5] + l * DM, scr, r, lane, MapIn()); continue; } r -= I_IN;
        if (r < I_UQ) { transpose_item(a.in[10] + (size_t)l * 256 * NQ, 256, NQ, wptr(ws_, l, OFF_UQ), NQ, a.in[9] + l * 256, scr, r, lane, MapUq()); continue; } r -= I_UQ;
        if (r < I_UKV) { transpose_item(a.in[12] + (size_t)l * 128 * NKV, 128, NKV, wptr(ws_, l, OFF_UKV), NKV, a.in[11] + l * 128, scr, r, lane, MapId()); continue; } r -= I_UKV;
        transpose_item(a.in[16] + (size_t)l * DM * DM, DM, DM, wptr(ws_, l, OFF_OUT), DM, nullptr, scr, r, lane, MapId());
    }
    for (int idx = (gw * 64 + lane); idx < 2 * 4 * 128 * 128 / 4; idx += NGW * 64) {
        const int l = idx / (4 * 128 * 128 / 4), e = idx % (4 * 128 * 128 / 4);
        const f32x4 v = *(const f32x4*)(a.in[14] + (size_t)l * 65536 + 4 * e);
        u32x2 o; o.x = cvtpk(v[0], v[1]); o.y = cvtpk(v[2], v[3]);
        *(u32x2*)(wptr(ws_, l, OFF_GWS) + 4 * e) = o;
    }
}

constexpr int RP = 4;
__device__ __forceinline__ void wave_sum4(float (&s)[RP], int lane) {
#pragma unroll
    for (int o = 1; o < 64; o <<= 1) {
        float t[RP];
#pragma unroll
        for (int k = 0; k < RP; ++k) t[k] = shflx(s[k], o, lane);
#pragma unroll
        for (int k = 0; k < RP; ++k) s[k] += t[k];
    }
}
__device__ __forceinline__ void bf8_to_f32(const u32x4 w, f32x4& a, f32x4& b) { a = (f32x4){bflo(w.x), bfhi(w.x), bflo(w.y), bfhi(w.y)}; b = (f32x4){bflo(w.z), bfhi(w.z), bflo(w.w), bfhi(w.w)}; }
__device__ __forceinline__ void row_pass(const float* __restrict__ xf, const bf16_t* xb, const bf16_t* __restrict__ H, float coef, const float* __restrict__ gpost,
                                         float* __restrict__ xout, bf16_t* XB, float* SC, int gw, int NGW, int lane) {
    f32x4 gp[2][2];
#pragma unroll
    for (int j = 0; j < 2; ++j)
#pragma unroll
        for (int q = 0; q < 2; ++q) gp[j][q] = H ? *(const f32x4*)(gpost + 8 * lane + 512 * j + 4 * q) * coef : (f32x4){0.f, 0.f, 0.f, 0.f};
#define RP_ROW0(rit_) ((NGW * RP == 8192) ? (32 * (4 * (((rit_) >> 13) & 1) + ((((rit_) & 8191) >> 8) >> 3)) + 8 * (3 - ((rit_) >> 14)) + ((((rit_) & 8191) >> 8) & 7)) * 256 + ((rit_) & 255) : (rit_))
    if (!xf && H) {
        u32x4 xw[RP][2], hw[RP][2]; float scv[RP];
        int rit = gw * RP, row0 = RP_ROW0(rit);
#pragma unroll
        for (int k = 0; k < RP; ++k) { scv[k] = SC[row0 + k];
#pragma unroll
            for (int j = 0; j < 2; ++j) { xw[k][j] = *(const u32x4*)(xb + (size_t)(row0 + k) * DM + 8 * lane + 512 * j); hw[k][j] = *(const u32x4*)(H + (size_t)(row0 + k) * DM + 8 * lane + 512 * j); } }
#pragma unroll 1
        for (; rit < T_TOK; rit += NGW * RP) {
            const int rnx = rit + NGW * RP; const bool more = rnx < T_TOK; const int row1 = more ? RP_ROW0(rnx) : row0;
            u32x4 xn_[RP][2], hn_[RP][2]; float scn[RP];
#pragma unroll
            for (int k = 0; k < RP; ++k) { scn[k] = SC[row1 + k];
#pragma unroll
                for (int j = 0; j < 2; ++j) { xn_[k][j] = *(const u32x4*)(xb + (size_t)(row1 + k) * DM + 8 * lane + 512 * j); hn_[k][j] = *(const u32x4*)(H + (size_t)(row1 + k) * DM + 8 * lane + 512 * j); } }
            f32x4 v[RP][2][2]; float ss[RP];
#pragma unroll
            for (int k = 0; k < RP; ++k) { ss[k] = 0.f;
#pragma unroll
                for (int j = 0; j < 2; ++j) { f32x4 h0, h1; bf8_to_f32(hw[k][j], h0, h1); ss[k] += sumsq4(h0) + sumsq4(h1); } }
            wave_sum4(ss, lane);
#pragma unroll
            for (int k = 0; k < RP; ++k) { const float rstd = 1.0f / sqrtf(ss[k] * (1.0f / DM) + EPS);
#pragma unroll
                for (int j = 0; j < 2; ++j) { f32x4 h0, h1, x0, x1; bf8_to_f32(hw[k][j], h0, h1); bf8_to_f32(xw[k][j], x0, x1);
                    v[k][j][0] = x0 * scv[k] + h0 * rstd * gp[j][0]; v[k][j][1] = x1 * scv[k] + h1 * rstd * gp[j][1]; } }
            if (xout) {
#pragma unroll
                for (int k = 0; k < RP; ++k)
#pragma unroll
                    for (int j = 0; j < 2; ++j)
#pragma unroll
                        for (int q = 0; q < 2; ++q) *(f32x4*)(xout + (size_t)(row0 + k) * DM + 8 * lane + 512 * j + 4 * q) = v[k][j][q];
            }
            if (XB) {
#pragma unroll
                for (int k = 0; k < RP; ++k) { ss[k] = 0.f;
#pragma unroll
                    for (int j = 0; j < 2; ++j) ss[k] += sumsq4(v[k][j][0]) + sumsq4(v[k][j][1]); }
                wave_sum4(ss, lane);
#pragma unroll
                for (int k = 0; k < RP; ++k) { const float ms = ss[k] * (1.0f / DM) + EPS; const float rstd = 1.0f / sqrtf(ms);
#pragma unroll
                    for (int j = 0; j < 2; ++j) *(u32x4*)(XB + (size_t)(row0 + k) * DM + 8 * lane + 512 * j) = pack8(v[k][j][0] * rstd, v[k][j][1] * rstd);
                    if (lane == 0) SC[row0 + k] = sqrtf(ms); }
            }
#pragma unroll
            for (int k = 0; k < RP; ++k) { scv[k] = scn[k];
#pragma unroll
                for (int j = 0; j < 2; ++j) { xw[k][j] = xn_[k][j]; hw[k][j] = hn_[k][j]; } }
            row0 = row1;
        }
        return;
    }
#pragma unroll 1
    for (int rit = gw * RP; rit < T_TOK; rit += NGW * RP) {
        int row0 = rit;
        if (NGW * RP == 8192) { const int j = rit >> 13, li = rit & 8191, pl = li >> 8; row0 = (32 * (4 * (j & 1) + (pl >> 3)) + 8 * (3 - (j >> 1)) + (pl & 7)) * 256 + (li & 255); }
        f32x4 v[RP][2][2]; u32x4 hw[RP][2];
        if (xf) {
#pragma unroll
            for (int k = 0; k < RP; ++k)
#pragma unroll
                for (int j = 0; j < 2; ++j)
#pragma unroll
                    for (int q = 0; q < 2; ++q) v[k][j][q] = *(const f32x4*)(xf + (size_t)(row0 + k) * DM + 8 * lane + 512 * j + 4 * q);
        } else {
#pragma unroll
            for (int k = 0; k < RP; ++k) { const float sc = SC[row0 + k];
#pragma unroll
                for (int j = 0; j < 2; ++j) { const u32x4 w = *(const u32x4*)(xb + (size_t)(row0 + k) * DM + 8 * lane + 512 * j); bf8_to_f32(w, v[k][j][0], v[k][j][1]); v[k][j][0] = v[k][j][0] * sc; v[k][j][1] = v[k][j][1] * sc; } }
        }
        if (H) {
#pragma unroll
            for (int k = 0; k < RP; ++k)
#pragma unroll
                for (int j = 0; j < 2; ++j) hw[k][j] = *(const u32x4*)(H + (size_t)(row0 + k) * DM + 8 * lane + 512 * j);
            float ss[RP];
#pragma unroll
            for (int k = 0; k < RP; ++k) { ss[k] = 0.f;
#pragma unroll
                for (int j = 0; j < 2; ++j) { f32x4 h0, h1; bf8_to_f32(hw[k][j], h0, h1); ss[k] += sumsq4(h0) + sumsq4(h1); } }
            wave_sum4(ss, lane);
#pragma unroll
            for (int k = 0; k < RP; ++k) { const float rstd = 1.0f / sqrtf(ss[k] * (1.0f / DM) + EPS);
#pragma unroll
                for (int j = 0; j < 2; ++j) { f32x4 h0, h1; bf8_to_f32(hw[k][j], h0, h1); v[k][j][0] = v[k][j][0] + h0 * rstd * gp[j][0]; v[k][j][1] = v[k][j][1] + h1 * rstd * gp[j][1]; } }
        }
        if (xout) {
#pragma unroll
            for (int k = 0; k < RP; ++k)
#pragma unroll
                for (int j = 0; j < 2; ++j)
#pragma unroll
                    for (int q = 0; q < 2; ++q) *(f32x4*)(xout + (size_t)(row0 + k) * DM + 8 * lane + 512 * j + 4 * q) = v[k][j][q];
        }
        if (XB) {
            float ss[RP];
#pragma unroll
            for (int k = 0; k < RP; ++k) { ss[k] = 0.f;
#pragma unroll
                for (int j = 0; j < 2; ++j) ss[k] += sumsq4(v[k][j][0]) + sumsq4(v[k][j][1]); }
            wave_sum4(ss, lane);
#pragma unroll
            for (int k = 0; k < RP; ++k) { const float ms = ss[k] * (1.0f / DM) + EPS; const float rstd = 1.0f / sqrtf(ms);
#pragma unroll
                for (int j = 0; j < 2; ++j) *(u32x4*)(XB + (size_t)(row0 + k) * DM + 8 * lane + 512 * j) = pack8(v[k][j][0] * rstd, v[k][j][1] * rstd);
                if (lane == 0) SC[row0 + k] = sqrtf(ms); }
        }
    }
}

__device__ __forceinline__ void unpack8(const u32x4 w, float (&o)[8]) { o[0] = bflo(w.x); o[1] = bfhi(w.x); o[2] = bflo(w.y); o[3] = bfhi(w.y); o[4] = bflo(w.z); o[5] = bfhi(w.z); o[6] = bflo(w.w); o[7] = bfhi(w.w); }
__device__ __forceinline__ void conv_phase(const bf16_t* __restrict__ ZC, const float* __restrict__ cw, const float* __restrict__ cb, bf16_t* __restrict__ Y, int gtid, int gthreads) {
    for (int item = gtid; item < (T_TOK / 16) * 32; item += gthreads) {
        const int ch = item & 31, rb = item >> 5, t0 = rb * 16, c0 = ch * 8;
        float w0[8], w1[8], w2[8], bb[8];
#pragma unroll
        for (int e = 0; e < 8; ++e) { w0[e] = cw[c0 + e]; w1[e] = cw[256 + c0 + e]; w2[e] = cw[512 + c0 + e]; bb[e] = cb[c0 + e]; }
        float zp[8], zc[8], zn[8];
        {
            if ((t0 & (SEQ - 1)) != 0) { float x[8], g[8]; unpack8(*(const u32x4*)(ZC + (size_t)(t0 - 1) * 768 + c0), x); unpack8(*(const u32x4*)(ZC + (size_t)(t0 - 1) * 768 + 512 + c0), g);
#pragma unroll
                for (int e = 0; e < 8; ++e) zp[e] = x[e] * g[e]; }
            else {
#pragma unroll
                for (int e = 0; e < 8; ++e) zp[e] = 0.f; }
            float x[8], g[8]; unpack8(*(const u32x4*)(ZC + (size_t)t0 * 768 + c0), x); unpack8(*(const u32x4*)(ZC + (size_t)t0 * 768 + 512 + c0), g);
#pragma unroll
            for (int e = 0; e < 8; ++e) zc[e] = x[e] * g[e];
        }
        for (int i = 0; i < 16; ++i) {
            const int t = t0 + i;
            if (((t + 1) & (SEQ - 1)) != 0) { float x[8], g[8]; unpack8(*(const u32x4*)(ZC + (size_t)(t + 1) * 768 + c0), x); unpack8(*(const u32x4*)(ZC + (size_t)(t + 1) * 768 + 512 + c0), g);
#pragma unroll
                for (int e = 0; e < 8; ++e) zn[e] = x[e] * g[e]; }
            else {
#pragma unroll
                for (int e = 0; e < 8; ++e) zn[e] = 0.f; }
            float gbv[8]; unpack8(*(const u32x4*)(ZC + (size_t)t * 768 + 256 + c0), gbv);
            float o[8];
#pragma unroll
            for (int e = 0; e < 8; ++e) o[e] = gbv[e] * (w0[e] * zp[e] + w1[e] * zc[e] + w2[e] * zn[e] + bb[e]);
            u32x4 w; w.x = cvtpk(o[0], o[1]); w.y = cvtpk(o[2], o[3]); w.z = cvtpk(o[4], o[5]); w.w = cvtpk(o[6], o[7]);
            *(u32x4*)(Y + (size_t)t * DM + c0) = w;
#pragma unroll
            for (int e = 0; e < 8; ++e) { zp[e] = zc[e]; zc[e] = zn[e]; }
        }
    }
}

__device__ __forceinline__ int lane_id() { int l; asm volatile("v_mbcnt_lo_u32_b32 %0, -1, 0\n\tv_mbcnt_hi_u32_b32 %0, -1, %0" : "=v"(l)); return l; }
#define MFMA32(a, b, c) __builtin_amdgcn_mfma_f32_32x32x16_bf16((a), (b), (c), 0, 0, 0)
__device__ __forceinline__ int crow(int i, int h) { return (i & 3) + 8 * (i >> 2) + 4 * h; }
template <int S> __device__ __forceinline__ bf16x8 packstep(const f32x16& x) {
    u32x4 p; p.x = cvtpk(x[8 * S], x[8 * S + 1]); p.y = cvtpk(x[8 * S + 2], x[8 * S + 3]); p.z = cvtpk(x[8 * S + 4], x[8 * S + 5]); p.w = cvtpk(x[8 * S + 6], x[8 * S + 7]);
    return __builtin_bit_cast(bf16x8, p);
}
typedef short v4i16_t __attribute__((ext_vector_type(4)));
__device__ __forceinline__ s16x4 tr_read(LAS unsigned char* p) { return __builtin_bit_cast(s16x4, __builtin_amdgcn_ds_read_tr16_b64_v4i16((LAS v4i16_t*)p)); }

constexpr int GM_PITCH = 272;
__device__ __forceinline__ void gmlp_phase(LAS unsigned char* lds, const bf16_t* __restrict__ U, const bf16_t* __restrict__ V, const float* __restrict__ PV, const float* __restrict__ gng,
                                           const bf16_t* __restrict__ WS, const float* __restrict__ bias, bf16_t* __restrict__ Y, int gw, int NGW, int wave, int lane) {
    LAS unsigned char* vt = lds + wave * (64 * GM_PITCH);
    const int r = lane & 31, hh = lane >> 5;
    for (int unit = gw; unit < 2048; unit += NGW) {
        const int g = unit & 3, bc = unit >> 2; const size_t row0 = (size_t)bc * 128;
        {
            const int ch = lane & 7; float gn[8];
#pragma unroll
            for (int e = 0; e < 8; ++e) gn[e] = gng[g * 64 + ch * 8 + e];
#pragma unroll 4
            for (int it = 0; it < 16; ++it) {
                const int q = it * 8 + (lane >> 3);
                const f32x4 p = *(const f32x4*)(PV + (row0 + q) * 4);
                const float rstd = 1.0f / sqrtf(((p[0] + p[1]) + (p[2] + p[3])) * (1.0f / 256.0f) + EPS);
                float x[8]; unpack8(*(const u32x4*)(V + (row0 + q) * 256 + g * 64 + ch * 8), x);
#pragma unroll
                for (int e = 0; e < 8; ++e) *(LAS unsigned short*)(vt + (ch * 8 + e) * GM_PITCH + q * 2) = f2bf(x[e] * rstd * gn[e]);
            }
        }
        asm volatile("s_waitcnt lgkmcnt(0)" ::: "memory");
        bf16x8 bfr[2][8];
#pragma unroll
        for (int dt = 0; dt < 2; ++dt)
#pragma unroll
            for (int ks = 0; ks < 8; ++ks) bfr[dt][ks] = *(LAS bf16x8*)(vt + (32 * dt + r) * GM_PITCH + (16 * ks + 8 * hh) * 2);
#pragma unroll 1
        for (int pt = 0; pt < 4; ++pt) {
            f32x16 o0 = {}, o1 = {};
            const bf16_t* wp = WS + ((size_t)(g * 128 + 32 * pt + r)) * 128 + 8 * hh;
#pragma unroll
            for (int ks = 0; ks < 8; ++ks) { const bf16x8 af = *(const bf16x8*)(wp + 16 * ks); o0 = MFMA32(bfr[0][ks], af, o0); o1 = MFMA32(bfr[1][ks], af, o1); }
            { const int pp = 32 * pt + r; const float bs = bias[g * 128 + pp];
              const bf16_t* up = U + (row0 + pp) * 256 + g * 64 + 4 * hh; bf16_t* yp = Y + (row0 + pp) * DM + 768 + g * 64 + 4 * hh;
#pragma unroll
              for (int q4 = 0; q4 < 4; ++q4) {
                  const u32x2 u0 = *(const u32x2*)(up + 8 * q4), u1 = *(const u32x2*)(up + 32 + 8 * q4);
                  u32x2 w0, w1;
                  w0.x = cvtpk(bflo(u0.x) * (o0[4 * q4] + bs), bfhi(u0.x) * (o0[4 * q4 + 1] + bs)); w0.y = cvtpk(bflo(u0.y) * (o0[4 * q4 + 2] + bs), bfhi(u0.y) * (o0[4 * q4 + 3] + bs));
                  w1.x = cvtpk(bflo(u1.x) * (o1[4 * q4] + bs), bfhi(u1.x) * (o1[4 * q4 + 1] + bs)); w1.y = cvtpk(bflo(u1.y) * (o1[4 * q4 + 2] + bs), bfhi(u1.y) * (o1[4 * q4 + 3] + bs));
                  *(u32x2*)(yp + 8 * q4) = w0; *(u32x2*)(yp + 32 + 8 * q4) = w1; } }
        }
        asm volatile("s_waitcnt lgkmcnt(0)" ::: "memory");
    }
}

__device__ __forceinline__ float xhalf_max(float m) { float a = m, b = m; asm volatile("v_nop\n\tv_nop\n\tv_permlane32_swap_b32 %0, %1" : "+v"(a), "+v"(b)); return fmaxf(a, b); }
__device__ __forceinline__ float xhalf_sum(float m) { float a = m, b = m; asm volatile("v_nop\n\tv_nop\n\tv_permlane32_swap_b32 %0, %1" : "+v"(a), "+v"(b)); return a + b; }
constexpr int AT_KP = 208, AT_VP = 144, AT_KB = 64 * AT_KP, AT_VB = 64 * AT_VP, AT_STAGE = AT_KB + AT_VB;
constexpr int AT_WSF = 2 * AT_STAGE, AT_QOFF = AT_WSF + 8 * 64 * 4, AT_QW = 64 * 192;
static_assert(AT_QOFF + 8 * AT_QW <= LDS_BYTES - 64, "attention LDS map");
#define FMAX2(a, b) __builtin_amdgcn_fmed3f((a), (b), __builtin_inff())
#define AT_SOFTMAX(s0, s1, m_run, l_run, oA, oB, wsfp) do { \
        float tmax = FMAX2(s0[0], s1[0]); \
        _Pragma("unroll") for (int i = 1; i < 16; ++i) tmax = FMAX2(tmax, FMAX2(s0[i], s1[i])); \
        tmax = xhalf_max(tmax); \
        if (__any(tmax > m_run + 8.0f)) { \
            const float m_new = fmaxf(m_run, tmax); const float f = __builtin_amdgcn_exp2f(m_run - m_new); m_run = m_new; l_run *= f; \
            if (hh == 0) (wsfp)[r] = f; \
            asm volatile("s_waitcnt lgkmcnt(0)" ::: "memory"); \
            _Pragma("unroll") for (int i = 0; i < 16; ++i) { const float fi = ((wsfp) + 4 * hh)[(i & 3) + 8 * (i >> 2)]; oA[i] *= fi; oB[i] *= fi; } \
        } \
        float ps = 0.f; \
        _Pragma("unroll") for (int i = 0; i < 16; ++i) { s0[i] = __builtin_amdgcn_exp2f(s0[i] - m_run); s1[i] = __builtin_amdgcn_exp2f(s1[i] - m_run); ps += s0[i] + s1[i]; } \
        l_run += ps; } while (0)

__device__ __forceinline__ void attn_phase(LAS unsigned char* lds, const bf16_t* __restrict__ Q, const bf16_t* __restrict__ KV, const bf16_t* __restrict__ KR, bf16_t* __restrict__ Y, int vcu, int G, const int tid) {
    const int lane = tid & 63, wid = __builtin_amdgcn_readfirstlane(tid >> 6), r = lane & 31, hh = lane >> 5;
    const int srow = tid >> 3, sch = tid & 7, rrow = (tid >> 2) & 63, rch = tid & 3;
    LAS float* wsf = (LAS float*)(lds + AT_WSF) + wid * 64;
    LAS unsigned char* qimg = lds + AT_QOFF + wid * AT_QW;
    const int i16 = lane & 15, tq = i16 >> 2, tp = i16 & 3, blk = (lane >> 4) & 1;
    const int voff = (4 * hh + tq) * AT_VP + blk * 32 + tp * 8;
    const int qsw = (r >> 2) & 3;
    for (int bh = vcu; bh < 256; bh += G) {
        const int b = bh >> 3, h = bh & 7; const size_t rowbase = (size_t)b * SEQ;
        const bf16_t* kvsrc = KV + (rowbase + srow) * NKV + h * 128 + sch * 8;
        const bf16_t* krsrc = KR + (rowbase + rrow) * 32 + rch * 8;
#pragma unroll 1
        for (int qb = 0; qb < 4; ++qb) {
            {
                const bf16_t* qsrc = Q + (rowbase + qb * 512 + wid * 64 + lane) * NQ + h * 96;
                const int key = (lane >> 2) & 3;
#pragma unroll
                for (int bq = 0; bq < 4; ++bq) { LAS unsigned char* dst = qimg + lane * 192 + ((bq ^ key) << 4);
#pragma unroll
                    for (int aq = 0; aq < 3; ++aq) *(LAS u32x4*)(dst + 64 * aq) = *(const u32x4*)(qsrc + (4 * aq + bq) * 8); }
            }
            u32x4 gk = *(const u32x4*)(kvsrc), gv = *(const u32x4*)(kvsrc + 64), gr = (u32x4){0u, 0u, 0u, 0u};
            if (tid < 256) gr = *(const u32x4*)(krsrc);
            float ma = -1e30f, la = 0.f, mb = -1e30f, lb = 0.f; f32x16 oa0 = {}, oa1 = {}, ob0 = {}, ob1 = {};
#pragma unroll 1
            for (int t = 0; t < SEQ / 64; ++t) {
                LAS unsigned char* kb = lds + (t & 1) * AT_STAGE; LAS unsigned char* vb = kb + AT_KB;
                *(LAS u32x4*)(kb + srow * AT_KP + sch * 16) = gk;
                *(LAS u32x4*)(vb + srow * AT_VP + sch * 16) = gv;
                if (tid < 256) *(LAS u32x4*)(kb + rrow * AT_KP + 128 + rch * 16) = gr;
                __syncthreads();
                if (t + 1 < SEQ / 64) { const size_t adv = (size_t)(t + 1) * 64;
                    gk = *(const u32x4*)(kvsrc + adv * NKV); gv = *(const u32x4*)(kvsrc + adv * NKV + 64);
                    if (tid < 256) gr = *(const u32x4*)(krsrc + adv * 32); }
                f32x16 sa0 = {}, sa1 = {}, sb0 = {}, sb1 = {};
#pragma unroll
                for (int ks = 0; ks < 6; ++ks) {
                    const bf16x8 k0 = *(LAS bf16x8*)(kb + r * AT_KP + ks * 32 + hh * 16);
                    const bf16x8 k1 = *(LAS bf16x8*)(kb + (32 + r) * AT_KP + ks * 32 + hh * 16);
                    const int qc = ((2 * ks + hh) ^ qsw) << 4;
                    const bf16x8 qa = *(LAS bf16x8*)(qimg + r * 192 + qc);
                    const bf16x8 qb2 = *(LAS bf16x8*)(qimg + (32 + r) * 192 + qc);
                    sa0 = MFMA32(k0, qa, sa0); sa1 = MFMA32(k1, qa, sa1);
                    sb0 = MFMA32(k0, qb2, sb0); sb1 = MFMA32(k1, qb2, sb1);
                }
                AT_SOFTMAX(sa0, sa1, ma, la, oa0, oa1, wsf);
                const bf16x8 pa00 = packstep<0>(sa0), pa01 = packstep<1>(sa0), pa10 = packstep<0>(sa1), pa11 = packstep<1>(sa1);
                AT_SOFTMAX(sb0, sb1, mb, lb, ob0, ob1, wsf + 32);
                const bf16x8 pb00 = packstep<0>(sb0), pb01 = packstep<1>(sb0), pb10 = packstep<0>(sb1), pb11 = packstep<1>(sb1);
#define PVSTEP(pa, pb, kv0) do { \
                    const s16x4 l0 = tr_read(vb + (kv0) * AT_VP + voff), h0 = tr_read(vb + ((kv0) + 8) * AT_VP + voff); \
                    const s16x4 l1 = tr_read(vb + (kv0) * AT_VP + voff + 64), h1 = tr_read(vb + ((kv0) + 8) * AT_VP + voff + 64); \
                    const bf16x8 v0 = __builtin_shufflevector(l0, h0, 0, 1, 2, 3, 4, 5, 6, 7), v1 = __builtin_shufflevector(l1, h1, 0, 1, 2, 3, 4, 5, 6, 7); \
                    oa0 = MFMA32(pa, v0, oa0); oa1 = MFMA32(pa, v1, oa1); ob0 = MFMA32(pb, v0, ob0); ob1 = MFMA32(pb, v1, ob1); } while (0)
                PVSTEP(pa00, pb00, 0); PVSTEP(pa01, pb01, 16); PVSTEP(pa10, pb10, 32); PVSTEP(pa11, pb11, 48);
#undef PVSTEP
            }
            const float lta = xhalf_sum(la), ltb = xhalf_sum(lb);
            if (hh == 0) { wsf[r] = 1.0f / lta; wsf[32 + r] = 1.0f / ltb; }
            asm volatile("s_waitcnt lgkmcnt(0)" ::: "memory");
            bf16_t* yp = Y + (rowbase + qb * 512 + wid * 64 + 4 * hh) * DM + 256 + h * 64 + r;
            asm volatile("" : "+v"(yp));
            LAS float* wsfh = wsf + 4 * hh;
#pragma unroll
            for (int i = 0; i < 16; ++i) { const int q = (i & 3) + 8 * (i >> 2); const float fa = wsfh[q], fb = wsfh[32 + q];
                yp[(size_t)q * DM] = f2bf(oa0[i] * fa); yp[(size_t)q * DM + 32] = f2bf(oa1[i] * fa);
                yp[(size_t)(32 + q) * DM] = f2bf(ob0[i] * fb); yp[(size_t)(32 + q) * DM + 32] = f2bf(ob1[i] * fb); }
            __syncthreads();
        }
    }
}

#define XB_TMO      128
#define XB_XCNT(j)  (256  + 64 * (j))
#define XB_XSUB(j)  (1280 + 64 * (j))
#define XB_XGEN(j)  (2304 + 64 * (j))
#define XB_TOP      3328
#define XB_TOPGEN   3392
#define XCD_BAR_WORDS 3456
#define XB_SPIN_CAP (1u << 18)

__device__ __forceinline__ unsigned xb_ld(unsigned* p)              { return __hip_atomic_load(p, __ATOMIC_RELAXED, __HIP_MEMORY_SCOPE_AGENT); }
__device__ __forceinline__ unsigned xb_add(unsigned* p, unsigned v) { return __hip_atomic_fetch_add(p, v, __ATOMIC_RELAXED, __HIP_MEMORY_SCOPE_AGENT); }
__device__ __forceinline__ unsigned xb_xcc_id() { return (unsigned)__builtin_amdgcn_s_getreg((3 << 11) | 20) & 0xFu; }
#define XB_SPIN(cond, bar) do { unsigned _sp = 0; while (cond) { __builtin_amdgcn_s_sleep(1); \
    if ((++_sp & 255u) == 0u) { if (xb_ld(&(bar)[XB_TMO])) break; if (_sp > XB_SPIN_CAP) { atomicAdd(&(bar)[XB_TMO], 1u); break; } } } } while (0)

struct XcdBarrier {
    unsigned* bar; unsigned x;
    volatile LAS unsigned* st;
};

__device__ __forceinline__ XcdBarrier xcd_barrier_post(unsigned* bar, volatile LAS unsigned* st) {
    XcdBarrier b; b.bar = bar; b.x = xb_xcc_id(); b.st = st;
    if (threadIdx.x == 0) (void)xb_add(&bar[XB_XCNT(b.x)], 1u);
    return b;
}
__device__ __forceinline__ void xcd_barrier_complete(unsigned* bar, unsigned x, unsigned& nloc, unsigned& nx) {
    const unsigned G = gridDim.x * gridDim.y * gridDim.z;
    unsigned sum, cnt, mine, sp = 0u;
    for (;;) {
        sum = 0u; cnt = 0u; mine = 0u;
#pragma unroll
        for (unsigned j = 0; j < 16; ++j) { const unsigned c = xb_ld(&bar[XB_XCNT(j)]); sum += c; cnt += (c > 0u) ? 1u : 0u; mine = (j == x) ? c : mine; }
        if (sum == G) break;
        __builtin_amdgcn_s_sleep(1);
        if ((++sp & 255u) == 0u) { if (xb_ld(&bar[XB_TMO])) break; if (sp > XB_SPIN_CAP) { atomicAdd(&bar[XB_TMO], 1u); break; } }
    }
    nloc = mine > 0u ? mine : 1u; nx = cnt > 0u ? cnt : 1u;
}

__device__ __forceinline__ void xcd_barrier(const XcdBarrier& b) {
    asm volatile("s_waitcnt vmcnt(0)" ::: "memory");
    __syncthreads();
    if (threadIdx.x == 0) {
        unsigned* bar = b.bar;
        __builtin_amdgcn_s_waitcnt(0);
        unsigned nloc = b.st[0], nx = b.st[1];
        if (nloc == 0u) { xcd_barrier_complete(bar, b.x, nloc, nx); b.st[0] = nloc; b.st[1] = nx; }
        const unsigned old = xb_add(&bar[XB_XSUB(b.x)], 1u);
        const unsigned gen = old / nloc;
        if (old + 1u == (gen + 1u) * nloc) {
            __builtin_amdgcn_fence(__ATOMIC_RELEASE, "agent");
            asm volatile("s_waitcnt vmcnt(0)" ::: "memory");
            const unsigned og = xb_add(&bar[XB_TOP], 1u);
            const unsigned tg = og / nx;
            if (og + 1u == (tg + 1u) * nx) xb_add(&bar[XB_TOPGEN], 1u);
            else XB_SPIN(xb_ld(&bar[XB_TOPGEN]) == tg, bar);
            __builtin_amdgcn_fence(__ATOMIC_ACQUIRE, "agent");
            xb_add(&bar[XB_XGEN(b.x)], 1u);
            asm volatile("s_waitcnt vmcnt(0)" ::: "memory");
        } else {
            XB_SPIN(xb_ld(&bar[XB_XGEN(b.x)]) == gen, bar);
            __builtin_amdgcn_fence(__ATOMIC_ACQUIRE, "agent");
            asm volatile("s_waitcnt vmcnt(0)" ::: "memory");
        }
    }
    __syncthreads();
}


#ifndef REP_CONV
#define REP_CONV 1
#endif
#ifndef REP_GMLP
#define REP_GMLP 1
#endif
#ifndef REP_PRO
#define REP_PRO 1
#endif
#ifndef REP_RP
#define REP_RP 1
#endif
#ifndef REP_GU
#define REP_GU 1
#endif
#ifndef REP_DN
#define REP_DN 1
#endif
#ifndef REP_WIN
#define REP_WIN 1
#endif
#ifndef REP_MIX2
#define REP_MIX2 1
#endif
#define GEMM_CALL(EpiT, E, Aptr, Bptr, Mv, Nv, Kv) do { pg8::Gemm g_{(Aptr), (Bptr), (Mv), (Nv), (Kv)}; pg8::StaticOrder S_; S_.init((Mv), (Nv), G, (int)blockIdx.x); \
        int l_o_ = lane_id(); asm volatile("" : "+v"(l_o_)); pg8::gemm_phase<EpiT, pg8::StaticOrder, true, true>(lds, g_, S_, (E), wave * 64 + l_o_); __syncthreads(); } while (0)

__global__ void __launch_bounds__(NTHR, 2) mk_fwd(Args a) {
    extern __shared__ __attribute__((aligned(16))) unsigned char lds_raw[];
    LAS unsigned char* lds = (LAS unsigned char*)lds_raw;
    cg::grid_group grid = cg::this_grid();
    const int wave = __builtin_amdgcn_readfirstlane((int)threadIdx.x >> 6);
    const int G = gridDim.x, bx = blockIdx.x, vcu = (G % 8 == 0) ? (bx % 8) * (G / 8) + bx / 8 : bx;
    const int gw = vcu * NWAVES + wave, NGW = G * NWAVES, gthreads = G * NTHR;
    unsigned char* const ws_k = a.ws;
#define rope ((float*)(ws + WS_ROPE))
#define PQ ((float*)(ws + WS_PQ))
#define PKV ((float*)(ws + WS_PKV))
#define PV ((float*)(ws + WS_PV))
#define RSv ((float*)(ws + WS_RS))
#define XN ((bf16_t*)(ws + WS_XN))
#define ACT ((bf16_t*)(ws + WS_ACT))
#define ZC ((bf16_t*)(ws + WS_ZC))
#define CQ ((bf16_t*)(ws + WS_CQ))
#define Ub ((bf16_t*)(ws + WS_U))
#define Vb ((bf16_t*)(ws + WS_V))
#define CKV ((bf16_t*)(ws + WS_CKV))
#define KR ((bf16_t*)(ws + WS_KR))
#define Qb ((bf16_t*)(ws + WS_Q))
#define KVb ((bf16_t*)(ws + WS_KV))
#define Yb ((bf16_t*)(ws + WS_Y))
#define Hb ((bf16_t*)(ws + WS_H))
    float* X = a.out;
    volatile LAS unsigned* misc = (volatile LAS unsigned*)(lds + LDS_BYTES - 64);
    if (threadIdx.x < 2) misc[threadIdx.x] = 0u;
    if (bx == 0) { for (int i = threadIdx.x; i < XCD_BAR_WORDS; i += NTHR) ((unsigned*)(a.ws + 65536))[i] = 0u; }
    XcdBarrier xbar; xbar.bar = (unsigned*)(a.ws + 65536); xbar.x = 0; xbar.st = misc;
    int ph = 0;
    const int lo = a.ph_lo, hi = a.ph_hi;
#define RUN (ph >= lo && ph < hi)
#define OPAQUE_IDS unsigned long long wsv_ = (unsigned long long)ws_k; asm volatile("" : "+s"(wsv_)); unsigned char* ws = (unsigned char*)(__attribute__((address_space(1))) unsigned char*)wsv_; int lane_o_ = lane_id(); asm volatile("" : "+v"(lane_o_)); const int tid = wave * 64 + lane_o_; const int lane = tid & 63, gtid = bx * NTHR + tid; (void)lane; (void)gtid;
#define SEAM do { if (ph >= lo && ph + 1 < hi) { if (ph == 0) { grid.sync(); xbar = xcd_barrier_post((unsigned*)(a.ws + 65536), misc); } else xcd_barrier(xbar); } ++ph; } while (0)

    if (RUN) { OPAQUE_IDS
#ifndef NO_PRO
        _Pragma("unroll 1") for (int rr_ = 0; rr_ < REP_PRO; ++rr_) prologue_weights(a, ws, lds, gw, NGW, wave, lane);
#endif
        rope_table(rope, gtid, gthreads);
        row_pass(a.in[0], nullptr, nullptr, 0.f, nullptr, nullptr, XN, RSv, gw, NGW, lane);
    }
    SEAM;

#pragma unroll 1
    for (int sb = 0; sb < 6; ++sb) {
        const int l = sb / 3, kind = sb % 3;
        if (kind != 1) {
            #ifndef NO_GU
            _Pragma("unroll 1") for (int rep_ = 0; rep_ < REP_GU; ++rep_)
            if (RUN) { OPAQUE_IDS EpiSwiGLU E{ACT, RSv}; GEMM_CALL(EpiSwiGLU, E, XN, wptr(ws, l, kind == 0 ? OFF_GU1 : OFF_GU2), T_TOK, NGU, DM); }
#endif
            SEAM;
            #ifndef NO_DN
            _Pragma("unroll 1") for (int rep_ = 0; rep_ < REP_DN; ++rep_)
#ifdef PROBE_SPLIT_DN
            _Pragma("unroll 1") for (int half_ = 0; half_ < 2; ++half_) { OPAQUE_IDS EpiPlain E{Hb, DM};
                { pg8::Gemm g_{ACT, wptr(ws, l, kind == 0 ? OFF_DN1 : OFF_DN2), T_TOK, DM, DFF}; pg8::StaticOrder S_; S_.init(T_TOK, DM, G, (int)blockIdx.x); S_.i0 = 2 * half_; S_.iend = 2 * half_ + 2;
                  int l_o_ = lane_id(); asm volatile("" : "+v"(l_o_)); pg8::gemm_phase<EpiPlain, pg8::StaticOrder, true, true>(lds, g_, S_, E, wave * 64 + l_o_); __syncthreads(); }
                if (half_ == 0) xcd_barrier(xbar); }
#else
            if (RUN) { OPAQUE_IDS EpiPlain E{Hb, DM}; GEMM_CALL(EpiPlain, E, ACT, wptr(ws, l, kind == 0 ? OFF_DN1 : OFF_DN2), T_TOK, DM, DFF); }
#endif
#endif
            SEAM;
            if (RUN) { OPAQUE_IDS
                const float* gpost = a.in[kind == 0 ? 4 : 21] + l * DM;
                if (sb == 5) row_pass(nullptr, XN, Hb, 0.5f, gpost, X, nullptr, RSv, gw, NGW, lane);
                else row_pass(nullptr, XN, Hb, 0.5f, gpost, nullptr, XN, RSv, gw, NGW, lane);
            }
            SEAM;
        } else {
            #ifndef NO_WIN
            _Pragma("unroll 1") for (int rep_ = 0; rep_ < REP_WIN; ++rep_)
            if (RUN) { OPAQUE_IDS EpiWin E{ZC, CQ, Ub, Vb, CKV, KR, PQ, PV, PKV, rope, RSv}; GEMM_CALL(EpiWin, E, XN, wptr(ws, l, OFF_IN), T_TOK, NIN_P, DM); }
#endif
            SEAM;
            _Pragma("unroll 1") for (int rep_ = 0; rep_ < REP_MIX2; ++rep_)
            if (RUN) { OPAQUE_IDS
#ifndef NO_UQ
                { EpiUq E{Qb, PQ, rope}; GEMM_CALL(EpiUq, E, CQ, wptr(ws, l, OFF_UQ), T_TOK, NQ, 256); }
#endif
#ifndef NO_UKV
                { EpiUkv E{KVb, PKV}; GEMM_CALL(EpiUkv, E, CKV, wptr(ws, l, OFF_UKV), T_TOK, NKV, 128); }
#endif
#ifndef NO_CONV
                _Pragma("unroll 1") for (int rc_ = 0; rc_ < REP_CONV; ++rc_) { OPAQUE_IDS conv_phase(ZC, a.in[7] + l * 768, a.in[8] + l * 256, Yb, gtid, gthreads); }
#endif
#ifndef NO_GMLP
                _Pragma("unroll 1") for (int rg_ = 0; rg_ < REP_GMLP; ++rg_) { OPAQUE_IDS gmlp_phase(lds, Ub, Vb, PV, a.in[13] + l * 256, wptr(ws, l, OFF_GWS), a.in[15] + l * 512, Yb, gw, NGW, wave, lane); }
#endif
            }
            SEAM;
#ifndef NO_ATTN
            if (RUN) { OPAQUE_IDS attn_phase(lds, Qb, KVb, KR, Yb, vcu, G, tid); }
#ifdef PROBE_DUP_ATTN
            if (RUN) { __syncthreads(); OPAQUE_IDS attn_phase(lds, Qb, KVb, KR, Yb, vcu, G, tid); }
#endif
#endif
            SEAM;
#ifndef NO_OUT
            _Pragma("unroll 1") for (int rep_ = 0; rep_ < REP_WIN; ++rep_)
            if (RUN) { OPAQUE_IDS EpiPlain E{Hb, DM}; GEMM_CALL(EpiPlain, E, Yb, wptr(ws, l, OFF_OUT), T_TOK, DM, DM); }
#endif
            SEAM;
            if (RUN) { OPAQUE_IDS row_pass(nullptr, XN, Hb, 1.0f, a.in[17] + l * DM, nullptr, XN, RSv, gw, NGW, lane); }
            SEAM;
        }
    }
}
constexpr int N_PHASES = 1 + 2 * (3 + 5 + 3);

#ifndef MK_SPLIT
#define MK_SPLIT 0
#endif
extern "C" void kernel_launch(void* const* d_in, const int* in_sizes, int n_in, void* d_out, int out_size, void* d_ws, size_t ws_size, hipStream_t stream) {
    static int grid = 0;
    if (grid == 0) {
        if (n_in != 22 || out_size != T_TOK * DM || ws_size < WS_END) { fprintf(stderr, "kernel_launch: unexpected shapes n_in %d out %d ws %zu\n", n_in, out_size, ws_size); grid = -1; return; }
        int dev = 0, cus = 0, per_cu = 0;
        (void)hipGetDevice(&dev); (void)hipDeviceGetAttribute(&cus, hipDeviceAttributeMultiprocessorCount, dev);
        if (hipFuncSetAttribute((const void*)mk_fwd, hipFuncAttributeMaxDynamicSharedMemorySize, LDS_BYTES) != hipSuccess) { fprintf(stderr, "kernel_launch: hipFuncSetAttribute failed\n"); grid = -1; return; }
        if (hipOccupancyMaxActiveBlocksPerMultiprocessor(&per_cu, (const void*)mk_fwd, NTHR, LDS_BYTES) != hipSuccess || per_cu < 1) { fprintf(stderr, "kernel_launch: occupancy query says %d\n", per_cu); per_cu = 1; }
        (void)hipGetLastError();
        grid = cus * per_cu;
        if (grid > cus) grid = cus;
    }
    if (grid < 0) return;
    Args a{};
    for (int i = 0; i < 22; ++i) a.in[i] = (const float*)d_in[i];
    a.out = (float*)d_out; a.ws = (unsigned char*)d_ws;
#if MK_SPLIT
    for (int p = 0; p < N_PHASES; ++p) { a.ph_lo = p; a.ph_hi = p + 1; hipLaunchKernelGGL(mk_fwd, dim3(grid), dim3(NTHR), LDS_BYTES, stream, a); }
#else
    a.ph_lo = 0; a.ph_hi = N_PHASES;
    void* args[] = {&a};
    hipError_t e = hipLaunchCooperativeKernel((const void*)mk_fwd, dim3(grid), dim3(NTHR), args, LDS_BYTES, stream);
    if (e != hipSuccess) fprintf(stderr, "cooperative launch failed: %s (grid %d)\n", hipGetErrorString(e), grid);
#endif
}
```

```cpp
#include <hip/hip_runtime.h>
#include <hip/hip_cooperative_groups.h>
#include <cstdio>
#include <cstdint>
namespace cg = cooperative_groups;
namespace pg8 {
#define PG8_LAS __attribute__((address_space(3)))
typedef unsigned short bf16_t;
typedef short bf16x8 __attribute__((ext_vector_type(8)));
typedef float f32x4 __attribute__((ext_vector_type(4)));
typedef unsigned u32x4 __attribute__((ext_vector_type(4)));
constexpr int BM = 256, BK = 64, HALF = 128, HTB = HALF * BK * 2  , STAGE_BYTES = 8 * HTB, NXCD = 8, WGM = 8;

__host__ __device__ __forceinline__ int lds_byte(int r, int c) { const int st = (r >> 4) * 2 + (c >> 5), rr = r & 15, cc = c & 31, ob = rr * 64 + cc * 2; return st * 1024 + (ob ^ (((ob >> 9) & 1) << 5)); }
__host__ __device__ __forceinline__ void stage_rc(int b, int& R, int& C) { const int st = b / 1024, sb = b % 1024, swz = sb ^ (((sb >> 9) & 1) << 5); R = (st >> 1) * 16 + swz / 64; C = (st & 1) * 32 + (swz % 64) / 2; }
__host__ __device__ __forceinline__ int perm32(int rho) { const int n = rho >> 4, i = rho & 15; return 8 * (i >> 2) + 4 * n + (i & 3); }

struct Unit { int pm, pn; };
struct Gemm { const bf16_t* A; const bf16_t* Bt; int M, N, K; };

struct StaticOrder {
    int nM, nN, nwg, G, c, i0, iend;
    __host__ __device__ void init(int M, int N, int G_, int c_) { nM = M / BM; nN = N / BM; nwg = nM * nN; G = G_; c = c_; i0 = 0; iend = 1 << 30; }
    __host__ __device__ bool next(int i, Unit& u) const {
        const long L = (long)(i + i0) * G + c; if (i + i0 >= iend || L >= nwg) return false;
        int wgid = (int)L; { const int q = nwg / NXCD, r = nwg % NXCD, xcd = wgid % NXCD, off = wgid / NXCD; wgid = (xcd < r ? xcd * (q + 1) : r * (q + 1) + (xcd - r) * q) + off; }
        const int nig = WGM * nN, gid = wgid / nig, fm = gid * WGM, gsz = (nM - fm) < WGM ? (nM - fm) : WGM;
        u.pm = fm + ((wgid % nig) % gsz); u.pn = (wgid % nig) / gsz; return true;
    }
    __device__ __forceinline__ void a_ready(const Unit&) const {}
    __device__ __forceinline__ void done(const Unit&) const {}
};

__device__ __forceinline__ unsigned cvt_pk_bf16(float lo, float hi) { unsigned r; asm volatile("v_cvt_pk_bf16_f32 %0, %1, %2" : "=v"(r) : "v"(lo), "v"(hi)); return r; }
typedef float f32x2 __attribute__((ext_vector_type(2)));
__device__ __forceinline__ f32x2 gelu_pk(f32x2 v) {
    const f32x2 av = __builtin_elementwise_abs(v), d = av * 0.2316418882f + 1.0f;
    f32x2 t; t.x = __builtin_amdgcn_rcpf(d.x); t.y = __builtin_amdgcn_rcpf(d.y);
    f32x2 q = t * 0.5307027145f + (-0.7265760135f); q = q * t + 0.7107068705f; q = q * t + (-0.142248368f); q = q * t + 0.127414796f; q = q * t;
    const f32x2 s = (v * v) * (-0.72134752044f);
    f32x2 e; e.x = __builtin_amdgcn_exp2f(s.x); e.y = __builtin_amdgcn_exp2f(s.y);
    const f32x2 m = v * (q * e), r = v - m;
    f32x2 o; o.x = v.x < 0.f ? m.x : r.x; o.y = v.y < 0.f ? m.y : r.y; return o;
}
template <class Epi, class Sched, bool ALIGN_EPI = false, bool SP2 = false>
__device__ __forceinline__ void gemm_phase(PG8_LAS unsigned char* lds, const Gemm g, const Sched& S, const Epi& E, const int tid_in) {
    const int tid = tid_in, wid = __builtin_amdgcn_readfirstlane(tid >> 6), lane = tid & 63, wr = wid >> 2, wc = wid & 3, fr = lane & 15, fq = lane >> 4;
    const int K = g.K, nt = K / BK;
    unsigned voffA[2], voffB[2];
#pragma unroll
    for (int i = 0; i < 2; ++i) { int R, C; stage_rc(tid * 16 + i * 8192, R, C); const int Rb = Epi::PERM ? ((R & ~31) + perm32(R & 31)) : R;
        voffA[i] = (unsigned)(R * K + C) * 2u; voffB[i] = (unsigned)(Rb * K + C) * 2u; }
    const size_t kstep = (size_t)(BK * 2);
    const size_t hstep = (size_t)HALF * K * 2;
    const size_t tstep = 2 * hstep;
    const unsigned ldsw = (unsigned)wid * 1024u;
    const int aoff = lds_byte(wr * 64 + fr, fq * 8), boff = lds_byte(wc * 32 + fr, fq * 8);
#define PG8_SA(b, h) (((b) * 2 + (h)) * HTB)
#define PG8_SB(b, h) ((4 + (b) * 2 + (h)) * HTB)
#define PG8_STAGE(bufoff, gbase, voff) do { _Pragma("unroll") for (int _i = 0; _i < 2; ++_i) \
        __builtin_amdgcn_global_load_lds((const unsigned*)((const char*)(gbase) + (voff)[_i]), (PG8_LAS unsigned*)(lds + (bufoff) + ldsw + _i * 8192), 16, 0, 0); } while (0)
#define PG8_LDA(dst, b, h) do { _Pragma("unroll") for (int m = 0; m < 4; ++m) _Pragma("unroll") for (int k = 0; k < 2; ++k) dst[m][k] = *(const PG8_LAS bf16x8*)(lds + PG8_SA(b, h) + aoff + m * 2048 + k * 1024); } while (0)
#define PG8_LDB(dst, b, h) do { _Pragma("unroll") for (int n = 0; n < 2; ++n) _Pragma("unroll") for (int k = 0; k < 2; ++k) dst[n][k] = *(const PG8_LAS bf16x8*)(lds + PG8_SB(b, h) + boff + n * 2048 + k * 1024); } while (0)
#define PG8_MMA(ai, bj, At, Bt) do { __builtin_amdgcn_s_setprio(1); _Pragma("unroll") for (int m = 0; m < 4; ++m) _Pragma("unroll") for (int n = 0; n < 2; ++n) _Pragma("unroll") for (int k = 0; k < 2; ++k) \
        acc[ai][bj][m][n] = __builtin_amdgcn_mfma_f32_16x16x32_bf16(Bt[n][k], At[m][k], acc[ai][bj][m][n], 0, 0, 0); __builtin_amdgcn_s_setprio(0); } while (0)
#define PG8_WAIT_V(n) asm volatile("s_waitcnt vmcnt(" #n ")" ::: "memory")
#define PG8_WAIT_L(n) asm volatile("s_waitcnt lgkmcnt(" #n ")" ::: "memory")
#define PG8_BAR __builtin_amdgcn_s_barrier()
#define PG8_SCHED __builtin_amdgcn_sched_barrier(0)
    Unit cur, nxt; int ui = 0;
    if (!S.next(0, cur)) return;
    f32x4 acc[2][2][4][2];
#pragma unroll
    for (int a = 0; a < 2; ++a)
#pragma unroll
        for (int b = 0; b < 2; ++b)
#pragma unroll
            for (int m = 0; m < 4; ++m)
#pragma unroll
                for (int n = 0; n < 2; ++n) acc[a][b][m][n] = (f32x4){0.f, 0.f, 0.f, 0.f};
    bf16x8 At[4][2], B0[2][2], B1[2][2];
    const char* cA = (const char*)g.A + (size_t)cur.pm * tstep; const char* cB = (const char*)g.Bt + (size_t)cur.pn * tstep;
    S.a_ready(cur);
    if constexpr (SP2) {
        PG8_STAGE(PG8_SB(0, 0), cB, voffB); PG8_STAGE(PG8_SB(0, 1), cB + hstep, voffB); PG8_STAGE(PG8_SA(0, 0), cA, voffA); PG8_STAGE(PG8_SA(0, 1), cA + hstep, voffA);
        if (wr == 1) PG8_BAR;
        PG8_WAIT_V(2); PG8_BAR;
        PG8_STAGE(PG8_SB(1, 0), cB + kstep, voffB); PG8_STAGE(PG8_SA(1, 0), cA + kstep, voffA); PG8_STAGE(PG8_SB(1, 1), cB + hstep + kstep, voffB);
        PG8_WAIT_V(6); PG8_BAR;
    } else {
        PG8_STAGE(PG8_SB(0, 0), cB, voffB); PG8_STAGE(PG8_SA(0, 0), cA, voffA); PG8_STAGE(PG8_SB(0, 1), cB + hstep, voffB); PG8_STAGE(PG8_SA(0, 1), cA + hstep, voffA);
        if (wr == 1) PG8_BAR;
        PG8_WAIT_V(4); PG8_BAR;
        PG8_STAGE(PG8_SB(1, 0), cB + kstep, voffB); PG8_STAGE(PG8_SA(1, 0), cA + kstep, voffA); PG8_STAGE(PG8_SB(1, 1), cB + hstep + kstep, voffB);
        PG8_WAIT_V(6); PG8_BAR;
    }
    for (;;) {
        const bool has_next = S.next(ui + 1, nxt);
        const char* nA = has_next ? (const char*)g.A + (size_t)nxt.pm * tstep : cA; const char* nB = has_next ? (const char*)g.Bt + (size_t)nxt.pn * tstep : cB;
        for (int t = 0; t < nt; t += 2) {
            const bool last = (t == nt - 2);
            const char* a1 = cA + (size_t)(t + 1) * kstep;
            const char* a2 = last ? nA : cA + (size_t)(t + 2) * kstep; const char* b2 = last ? nB : cB + (size_t)(t + 2) * kstep;
            const char* a3 = a2 + kstep; const char* b3 = b2 + kstep;
            if (last && has_next) S.a_ready(nxt);
            if constexpr (SP2) {
            PG8_LDB(B0, 0, 0); PG8_LDB(B1, 0, 1); PG8_SCHED; PG8_LDA(At, 0, 0); PG8_STAGE(PG8_SA(1, 1), a1 + hstep, voffA);
            PG8_WAIT_V(8); PG8_WAIT_L(0); PG8_BAR; PG8_MMA(0, 0, At, B0); PG8_MMA(0, 1, At, B1); PG8_BAR; PG8_SCHED;
            PG8_LDA(At, 0, 1); PG8_STAGE(PG8_SB(0, 0), b2, voffB); PG8_STAGE(PG8_SB(0, 1), b2 + hstep, voffB); PG8_STAGE(PG8_SA(0, 0), a2, voffA);
            PG8_WAIT_V(8); PG8_WAIT_L(0); PG8_BAR; PG8_MMA(1, 0, At, B0); PG8_MMA(1, 1, At, B1); PG8_BAR; PG8_SCHED;
            PG8_LDB(B0, 1, 0); PG8_LDB(B1, 1, 1); PG8_SCHED; PG8_LDA(At, 1, 0); PG8_STAGE(PG8_SA(0, 1), a2 + hstep, voffA);
            PG8_WAIT_V(8); PG8_WAIT_L(0); PG8_BAR; PG8_MMA(0, 0, At, B0); PG8_MMA(0, 1, At, B1); PG8_BAR; PG8_SCHED;
            PG8_LDA(At, 1, 1); PG8_STAGE(PG8_SB(1, 0), b3, voffB); PG8_STAGE(PG8_SB(1, 1), b3 + hstep, voffB); PG8_STAGE(PG8_SA(1, 0), a3, voffA);
            PG8_WAIT_V(8); PG8_WAIT_L(0); PG8_BAR; PG8_MMA(1, 0, At, B0); PG8_MMA(1, 1, At, B1); PG8_BAR; PG8_SCHED;
            } else {
            PG8_LDB(B0, 0, 0); PG8_SCHED; PG8_LDA(At, 0, 0); PG8_STAGE(PG8_SA(1, 1), a1 + hstep, voffA);
            PG8_WAIT_L(8); PG8_BAR; PG8_WAIT_L(0); PG8_MMA(0, 0, At, B0); PG8_BAR; PG8_SCHED;
            PG8_LDB(B1, 0, 1); PG8_STAGE(PG8_SB(0, 0), b2, voffB);
            PG8_BAR; PG8_WAIT_L(0); PG8_MMA(0, 1, At, B1); PG8_BAR;
            PG8_LDA(At, 0, 1); PG8_STAGE(PG8_SA(0, 0), a2, voffA);
            PG8_BAR; PG8_WAIT_L(0); PG8_MMA(1, 0, At, B0); PG8_BAR; PG8_SCHED;
            PG8_STAGE(PG8_SB(0, 1), b2 + hstep, voffB);
            PG8_WAIT_V(6); PG8_BAR; PG8_MMA(1, 1, At, B1); PG8_BAR;
            PG8_LDB(B0, 1, 0); PG8_SCHED; PG8_LDA(At, 1, 0); PG8_STAGE(PG8_SA(0, 1), a2 + hstep, voffA);
            PG8_WAIT_L(8); PG8_BAR; PG8_WAIT_L(0); PG8_MMA(0, 0, At, B0); PG8_BAR; PG8_SCHED;
            PG8_LDB(B1, 1, 1); PG8_STAGE(PG8_SB(1, 0), b3, voffB);
            PG8_BAR; PG8_WAIT_L(0); PG8_MMA(0, 1, At, B1); PG8_BAR;
            PG8_LDA(At, 1, 1); PG8_STAGE(PG8_SA(1, 0), a3, voffA);
            PG8_BAR; PG8_WAIT_L(0); PG8_MMA(1, 0, At, B0); PG8_BAR; PG8_SCHED;
            PG8_STAGE(PG8_SB(1, 1), b3 + hstep, voffB);
            PG8_WAIT_V(6); PG8_BAR; PG8_MMA(1, 1, At, B1); PG8_BAR;
            }
        }
        if constexpr (ALIGN_EPI) { if (wr == 0) PG8_BAR; }
        if constexpr (!Epi::AFTER_DRAIN) { E(acc, cur, wr, wc, fr, fq); S.done(cur); }
        if (!has_next) break;
#pragma unroll
        for (int a = 0; a < 2; ++a)
#pragma unroll
            for (int b = 0; b < 2; ++b)
#pragma unroll
                for (int m = 0; m < 4; ++m)
#pragma unroll
                    for (int n = 0; n < 2; ++n) acc[a][b][m][n] = (f32x4){0.f, 0.f, 0.f, 0.f};
        cur = nxt; cA = nA; cB = nB; ++ui;
        if constexpr (ALIGN_EPI) { if (wr == 1) PG8_BAR; }
    }
    PG8_WAIT_V(0);
    if constexpr (!ALIGN_EPI) { if (wr == 0) PG8_BAR; }
    PG8_BAR;
    if constexpr (Epi::AFTER_DRAIN) { E.fused(acc, cur, wr, wc, fr, fq, lds, wid, lane); S.done(cur); }
#undef PG8_SA
#undef PG8_SB
#undef PG8_STAGE
#undef PG8_LDA
#undef PG8_LDB
#undef PG8_MMA
#undef PG8_WAIT_V
#undef PG8_WAIT_L
#undef PG8_BAR
#undef PG8_SCHED
}
}

#define LAS __attribute__((address_space(3)))
using pg8::f32x4; using pg8::bf16_t; using pg8::Unit; using pg8::u32x4; using pg8::f32x2; using pg8::bf16x8;
typedef float f32x16 __attribute__((ext_vector_type(16)));
typedef short s16x4 __attribute__((ext_vector_type(4)));
typedef unsigned u32x2 __attribute__((ext_vector_type(2)));
typedef __bf16 bf16x2_t __attribute__((ext_vector_type(2)));

constexpr int T_TOK = 65536, SEQ = 2048, DM = 1024, DFF = 2816, NGU = 5632, NIN_P = 1792, NQ = 768, NKV = 1024;
constexpr float EPS = 1e-6f;
constexpr int NWAVES = 8, NTHR = 512;
constexpr int LDS_BYTES = 147456;
constexpr float QSCALE = 0.10206207261596575f * 1.4426950408889634f;

constexpr size_t MiB = 1u << 20;
constexpr size_t WS_ROPE = 1 * MiB;
constexpr size_t WS_PQ = 2 * MiB, WS_PKV = 3 * MiB, WS_PV = 4 * MiB, WS_RS = 5 * MiB;
constexpr size_t WS_W = 8 * MiB, WS_WL = 42 * MiB;
constexpr size_t WS_XN = 96 * MiB;
constexpr size_t WS_ACT = 224 * MiB;
constexpr size_t WS_ZC = 224 * MiB, WS_CQ = 320 * MiB, WS_U = 352 * MiB, WS_V = 384 * MiB, WS_CKV = 416 * MiB, WS_KR = 432 * MiB, WS_Q = 448 * MiB;
constexpr size_t WS_KV = 576 * MiB, WS_Y = 704 * MiB, WS_H = 832 * MiB, WS_END = 960 * MiB;

__device__ __forceinline__ unsigned cvtpk(float lo, float hi) { f32x2 v = {lo, hi}; bf16x2_t b = __builtin_convertvector(v, bf16x2_t); return __builtin_bit_cast(unsigned, b); }
__device__ __forceinline__ u32x4 pack8(f32x4 v0, f32x4 v1) { u32x4 w; w.x = cvtpk(v0[0], v0[1]); w.y = cvtpk(v0[2], v0[3]); w.z = cvtpk(v1[0], v1[1]); w.w = cvtpk(v1[2], v1[3]); return w; }
__device__ __forceinline__ unsigned short f2bf(float f) { unsigned u = __builtin_bit_cast(unsigned, f); return (unsigned short)((u + 0x7fffu + ((u >> 16) & 1u)) >> 16); }
__device__ __forceinline__ float bf2f(unsigned short b) { return __builtin_bit_cast(float, (unsigned)b << 16); }
__device__ __forceinline__ float bflo(unsigned w) { return __builtin_bit_cast(float, w << 16); }
__device__ __forceinline__ float bfhi(unsigned w) { return __builtin_bit_cast(float, w & 0xffff0000u); }
__device__ __forceinline__ float silu_mul(float g, float u) { return g * __builtin_amdgcn_rcpf(1.0f + __builtin_amdgcn_exp2f(-1.4426950408889634f * g)) * u; }
__device__ __forceinline__ f32x4 gelu4(f32x4 v) { f32x2 a = pg8::gelu_pk((f32x2){v[0], v[1]}), b = pg8::gelu_pk((f32x2){v[2], v[3]}); return (f32x4){a.x, a.y, b.x, b.y}; }
__device__ __forceinline__ float sumsq4(f32x4 v) { return (v[0] * v[0] + v[1] * v[1]) + (v[2] * v[2] + v[3] * v[3]); }
__device__ __forceinline__ float shflx(float v, int o, int lane) { return __builtin_bit_cast(float, __builtin_amdgcn_ds_bpermute((lane ^ o) << 2, __builtin_bit_cast(int, v))); }
__device__ __forceinline__ float wave_sum(float v, int lane) {
#pragma unroll
    for (int o = 1; o < 64; o <<= 1) v += shflx(v, o, lane);
    return v;
}

struct EpiPlain {
    static constexpr bool PERM = true, AFTER_DRAIN = false;
    bf16_t* O; int ldc;
    __device__ __forceinline__ void operator()(const f32x4 (&acc)[2][2][4][2], const Unit& u, int wr, int wc, int fr, int fq) const {
        const int row0 = u.pm * 256 + wr * 64 + fr, col0 = u.pn * 256 + wc * 32 + 8 * fq;
#pragma unroll
        for (int ai = 0; ai < 2; ++ai)
#pragma unroll
            for (int m = 0; m < 4; ++m) { bf16_t* rowp = O + (size_t)(row0 + ai * 128 + m * 16) * ldc + col0;
#pragma unroll
                for (int bj = 0; bj < 2; ++bj) *(u32x4*)(rowp + bj * 128) = pack8(acc[ai][bj][m][0], acc[ai][bj][m][1]); }
    }
};
struct EpiSwiGLU {
    static constexpr bool PERM = true, AFTER_DRAIN = false;
    bf16_t* O; const float* RS;
    __device__ __forceinline__ void operator()(const f32x4 (&acc)[2][2][4][2], const Unit& u, int wr, int wc, int fr, int fq) const {
        const int row0 = u.pm * 256 + wr * 64 + fr, col0 = u.pn * 128 + wc * 32 + 8 * fq;
#pragma unroll
        for (int ai = 0; ai < 2; ++ai)
#pragma unroll
            for (int m = 0; m < 4; ++m) {
                const f32x4 g0 = acc[ai][0][m][0], g1 = acc[ai][0][m][1], u0 = acc[ai][1][m][0], u1 = acc[ai][1][m][1];
                f32x4 r0, r1;
#pragma unroll
                for (int e = 0; e < 4; ++e) { r0[e] = silu_mul(g0[e], u0[e]); r1[e] = silu_mul(g1[e], u1[e]); }
                *(u32x4*)(O + (size_t)(row0 + ai * 128 + m * 16) * DFF + col0) = pack8(r0, r1);
            }
    }
};
struct EpiWin {
    static constexpr bool PERM = true, AFTER_DRAIN = false;
    bf16_t *ZC, *CQ, *U, *V, *CKV, *KR; float *PQ, *PV, *PKV; const float* rope; const float* RS;
    __device__ __forceinline__ void operator()(const f32x4 (&acc)[2][2][4][2], const Unit& u, int wr, int wc, int fr, int fq) const {
        const int row0 = u.pm * 256 + wr * 64 + fr, cw = wc * 32 + 8 * fq, pn = u.pn;
        if (pn < 3) {
#pragma unroll
            for (int ai = 0; ai < 2; ++ai)
#pragma unroll
                for (int m = 0; m < 4; ++m) { bf16_t* rowp = ZC + (size_t)(row0 + ai * 128 + m * 16) * 768 + pn * 256 + cw;
#pragma unroll
                    for (int bj = 0; bj < 2; ++bj) *(u32x4*)(rowp + bj * 128) = pack8(acc[ai][bj][m][0], acc[ai][bj][m][1]); }
        } else if (pn == 3) {
#pragma unroll
            for (int ai = 0; ai < 2; ++ai)
#pragma unroll
                for (int m = 0; m < 4; ++m) { const int row = row0 + ai * 128 + m * 16; bf16_t* rowp = CQ + (size_t)row * 256 + cw; float ss = 0.f;
#pragma unroll
                    for (int bj = 0; bj < 2; ++bj) { const f32x4 v0 = acc[ai][bj][m][0], v1 = acc[ai][bj][m][1]; ss += sumsq4(v0) + sumsq4(v1); *(u32x4*)(rowp + bj * 128) = pack8(v0, v1); }
                    ss += shflx(ss, 16, fq * 16 + fr); ss += shflx(ss, 32, fq * 16 + fr);
                    if (fq == 0) PQ[(size_t)row * 4 + wc] = ss; }
        } else if (pn == 4) {
#pragma unroll
            for (int ai = 0; ai < 2; ++ai)
#pragma unroll
                for (int m = 0; m < 4; ++m) { bf16_t* rowp = U + (size_t)(row0 + ai * 128 + m * 16) * 256 + cw;
#pragma unroll
                    for (int bj = 0; bj < 2; ++bj) *(u32x4*)(rowp + bj * 128) = pack8(gelu4(acc[ai][bj][m][0]), gelu4(acc[ai][bj][m][1])); }
        } else if (pn == 5) {
#pragma unroll
            for (int ai = 0; ai < 2; ++ai)
#pragma unroll
                for (int m = 0; m < 4; ++m) { const int row = row0 + ai * 128 + m * 16; bf16_t* rowp = V + (size_t)row * 256 + cw; float ss = 0.f;
#pragma unroll
                    for (int bj = 0; bj < 2; ++bj) { const f32x4 v0 = gelu4(acc[ai][bj][m][0]), v1 = gelu4(acc[ai][bj][m][1]); ss += sumsq4(v0) + sumsq4(v1); *(u32x4*)(rowp + bj * 128) = pack8(v0, v1); }
                    ss += shflx(ss, 16, fq * 16 + fr); ss += shflx(ss, 32, fq * 16 + fr);
                    if (fq == 0) PV[(size_t)row * 4 + wc] = ss; }
        } else {
#pragma unroll
            for (int ai = 0; ai < 2; ++ai)
#pragma unroll
                for (int m = 0; m < 4; ++m) { const int row = row0 + ai * 128 + m * 16;
                    const f32x4 v0 = acc[ai][0][m][0], v1 = acc[ai][0][m][1]; float ss = sumsq4(v0) + sumsq4(v1);
                    *(u32x4*)(CKV + (size_t)row * 128 + cw) = pack8(v0, v1);
                    ss += shflx(ss, 16, fq * 16 + fr); ss += shflx(ss, 32, fq * 16 + fr);
                    if (fq == 0) PKV[(size_t)row * 4 + wc] = ss;
                    if (wc == 0) {
                        const f32x4 a = acc[ai][1][m][0], b = acc[ai][1][m][1];
                        const f32x4* rp = (const f32x4*)(rope + ((size_t)(row & (SEQ - 1)) * 16 + 4 * fq) * 2);
                        const f32x4 c0 = rp[0], c1 = rp[1];
                        f32x4 ra, rb;
                        ra[0] = a[0] * c0[0] - a[1] * c0[1]; ra[1] = a[1] * c0[0] + a[0] * c0[1];
                        ra[2] = a[2] * c0[2] - a[3] * c0[3]; ra[3] = a[3] * c0[2] + a[2] * c0[3];
                        rb[0] = b[0] * c1[0] - b[1] * c1[1]; rb[1] = b[1] * c1[0] + b[0] * c1[1];
                        rb[2] = b[2] * c1[2] - b[3] * c1[3]; rb[3] = b[3] * c1[2] + b[2] * c1[3];
                        *(u32x4*)(KR + (size_t)row * 32 + 8 * fq) = pack8(ra, rb);
                    } }
        }
    }
};
struct EpiUq {
    static constexpr bool PERM = true, AFTER_DRAIN = false;
    bf16_t* Q; const float* PQ; const float* rope;
    __device__ __forceinline__ void operator()(const f32x4 (&acc)[2][2][4][2], const Unit& u, int wr, int wc, int fr, int fq) const {
        const int row0 = u.pm * 256 + wr * 64 + fr, col0 = u.pn * 256 + wc * 32 + 8 * fq;
#pragma unroll
        for (int ai = 0; ai < 2; ++ai)
#pragma unroll
            for (int m = 0; m < 4; ++m) { const int row = row0 + ai * 128 + m * 16;
                const f32x4 p = *(const f32x4*)(PQ + (size_t)row * 4);
                const float sc = QSCALE / sqrtf(((p[0] + p[1]) + (p[2] + p[3])) * (1.0f / 256.0f) + EPS);
#pragma unroll
                for (int bj = 0; bj < 2; ++bj) { const int c = col0 + bj * 128, w = c % 96;
                    f32x4 a = acc[ai][bj][m][0] * sc, b = acc[ai][bj][m][1] * sc;
                    if (w >= 64) {
                        const f32x4* rp = (const f32x4*)(rope + ((size_t)(row & (SEQ - 1)) * 16 + ((w - 64) >> 1)) * 2);
                        const f32x4 c0 = rp[0], c1 = rp[1]; f32x4 ra, rb;
                        ra[0] = a[0] * c0[0] - a[1] * c0[1]; ra[1] = a[1] * c0[0] + a[0] * c0[1];
                        ra[2] = a[2] * c0[2] - a[3] * c0[3]; ra[3] = a[3] * c0[2] + a[2] * c0[3];
                        rb[0] = b[0] * c1[0] - b[1] * c1[1]; rb[1] = b[1] * c1[0] + b[0] * c1[1];
                        rb[2] = b[2] * c1[2] - b[3] * c1[3]; rb[3] = b[3] * c1[2] + b[2] * c1[3];
                        a = ra; b = rb;
                    }
                    *(u32x4*)(Q + (size_t)row * NQ + c) = pack8(a, b); } }
    }
};
struct EpiUkv {
    static constexpr bool PERM = true, AFTER_DRAIN = false;
    bf16_t* KV; const float* PKV;
    __device__ __forceinline__ void operator()(const f32x4 (&acc)[2][2][4][2], const Unit& u, int wr, int wc, int fr, int fq) const {
        const int row0 = u.pm * 256 + wr * 64 + fr, col0 = u.pn * 256 + wc * 32 + 8 * fq;
#pragma unroll
        for (int ai = 0; ai < 2; ++ai)
#pragma unroll
            for (int m = 0; m < 4; ++m) { const int row = row0 + ai * 128 + m * 16;
                const f32x4 p = *(const f32x4*)(PKV + (size_t)row * 4);
                const float sc = 1.0f / sqrtf(((p[0] + p[1]) + (p[2] + p[3])) * (1.0f / 128.0f) + EPS);
#pragma unroll
                for (int bj = 0; bj < 2; ++bj) *(u32x4*)(KV + (size_t)row * NKV + col0 + bj * 128) = pack8(acc[ai][bj][m][0] * sc, acc[ai][bj][m][1] * sc); }
    }
};

struct MapId   { __device__ __forceinline__ int operator()(int n) const { return n; } };
struct MapGU   { __device__ __forceinline__ int operator()(int n) const { const int pn = n >> 8, w = n & 255; return w < 128 ? 128 * pn + w : DFF + 128 * pn + (w - 128); } };
struct MapIn   { __device__ __forceinline__ int operator()(int n) const {
    if (n < 1024) return n;
    if (n < 1280) return 1184 + (n - 1024);
    if (n < 1536) return 1440 + (n - 1280);
    if (n < 1664) return 1024 + (n - 1536);
    if (n < 1696) { const int j = n - 1664; return 1152 + (j >> 1) + 16 * (j & 1); }
    return -1; } };
struct MapUq   { __device__ __forceinline__ int operator()(int n) const { const int h = n / 96, w = n % 96; if (w < 64) return n; const int j = w - 64; return h * 96 + 64 + (j >> 1) + 16 * (j & 1); } };

template <class Map>
__device__ __forceinline__ void transpose_item(const float* __restrict__ W, int K, int Nsrc, bf16_t* __restrict__ WT, int Ndst, const float* __restrict__ gk, LAS float* scr, int item, int lane, Map map) {
    const int nblk = Ndst / 32, kb = item / nblk, nb = item % nblk, k0 = 64 * kb, n0 = 32 * nb;
    const int n4 = 4 * (lane & 7), ko = lane >> 3;
    const int s0 = map(n0 + n4), s1 = map(n0 + n4 + 1), s2 = map(n0 + n4 + 2), s3 = map(n0 + n4 + 3);
    const bool contig = (s0 >= 0) && (s1 == s0 + 1) && (s2 == s0 + 2) && (s3 == s0 + 3) && ((s0 & 3) == 0);
#pragma unroll
    for (int i = 0; i < 8; ++i) { const int kk = 8 * i + ko; f32x4 v = {0.f, 0.f, 0.f, 0.f};
        const float* wr = W + (size_t)(k0 + kk) * Nsrc;
        if (contig) v = *(const f32x4*)(wr + s0);
        else { if (s0 >= 0) v[0] = wr[s0]; if (s1 >= 0) v[1] = wr[s1]; if (s2 >= 0) v[2] = wr[s2]; if (s3 >= 0) v[3] = wr[s3]; }
        if (gk) v = v * gk[k0 + kk];
        LAS float* d = scr + kk * 33 + n4; d[0] = v[0]; d[1] = v[1]; d[2] = v[2]; d[3] = v[3]; }
    asm volatile("s_waitcnt lgkmcnt(0)" ::: "memory");
    const int c = lane & 7;
#pragma unroll
    for (int j = 0; j < 4; ++j) { const int n = (lane >> 3) + 8 * j; const LAS float* s = scr + (8 * c) * 33 + n;
        u32x4 o; o.x = cvtpk(s[0 * 33], s[1 * 33]); o.y = cvtpk(s[2 * 33], s[3 * 33]); o.z = cvtpk(s[4 * 33], s[5 * 33]); o.w = cvtpk(s[6 * 33], s[7 * 33]);
        *(u32x4*)(WT + (size_t)(n0 + n) * K + k0 + 8 * c) = o; }
    asm volatile("s_waitcnt lgkmcnt(0)" ::: "memory");
}

struct Args { const float* in[22]; float* out; unsigned char* ws; int ph_lo, ph_hi; };

__device__ __forceinline__ bf16_t* wptr(unsigned char* ws, int layer, size_t off) { return (bf16_t*)(ws + WS_W + (size_t)layer * WS_WL + off); }
constexpr size_t OFF_GU1 = 0, OFF_GU2 = 11 * MiB, OFF_DN1 = 22 * MiB, OFF_DN2 = 28 * MiB, OFF_IN = 34 * MiB, OFF_OUT = 38 * MiB,
                 OFF_UQ = 40 * MiB, OFF_UKV = 40 * MiB + 512 * 1024, OFF_GWS = 41 * MiB;

__device__ __forceinline__ void rope_table(float* rope, int gtid, int gthreads) {
    for (int idx = gtid; idx < SEQ * 16; idx += gthreads) {
        const int pos = idx >> 4, i = idx & 15;
        const float inv = 1.0f / exp2f((float)i * 0.8304820237218406f);
        const float ang = (float)pos * inv;
        const double rev = (double)ang * 0.15915494309189535;
        const float fr = (float)(rev - __builtin_rint(rev));
        rope[2 * idx] = __builtin_amdgcn_cosf(fr); rope[2 * idx + 1] = __builtin_amdgcn_sinf(fr);
    }
}
__device__ __forceinline__ void prologue_weights(const Args& a, unsigned char* ws_, LAS unsigned char* lds, int gw, int NGW, int wave, int lane) {
    LAS float* scr = (LAS float*)(lds + wave * 16384);
    constexpr int I_GU = 16 * (NGU / 32), I_DN = (DFF / 64) * 32, I_IN = 16 * (NIN_P / 32), I_UQ = 4 * (NQ / 32), I_UKV = 2 * 32, I_OUT = 16 * 32;
    constexpr int PER_LAYER = 2 * I_GU + 2 * I_DN + I_IN + I_UQ + I_UKV + I_OUT;
    for (int it = gw; it < 2 * PER_LAYER; it += NGW) {
        const int l = it / PER_LAYER; int r = it % PER_LAYER;
        if (r < I_GU) { transpose_item(a.in[2] + (size_t)l * DM * NGU, DM, NGU, wptr(ws_, l, OFF_GU1), NGU, a.in[1] + l * DM, scr, r, lane, MapGU()); continue; } r -= I_GU;
        if (r < I_GU) { transpose_item(a.in[19] + (size_t)l * DM * NGU, DM, NGU, wptr(ws_, l, OFF_GU2), NGU, a.in[18] + l * DM, scr, r, lane, MapGU()); continue; } r -= I_GU;
        if (r < I_DN) { transpose_item(a.in[3] + (size_t)l * DFF * DM, DFF, DM, wptr(ws_, l, OFF_DN1), DM, nullptr, scr, r, lane, MapId()); continue; } r -= I_DN;
        if (r < I_DN) { transpose_item(a.in[20] + (size_t)l * DFF * DM, DFF, DM, wptr(ws_, l, OFF_DN2), DM, nullptr, scr, r, lane, MapId()); continue; } r -= I_DN;
        if (r < I_IN) { transpose_item(a.in[6] + (size_t)l * DM * 1696, DM, 1696, wptr(ws_, l, OFF_IN), NIN_P, a.in[5] + l * DM, scr, r, lane, MapIn()); continue; } r -= I_IN;
        if (r < I_UQ) { transpose_item(a.in[10] + (size_t)l * 256 * NQ, 256, NQ, wptr(ws_, l, OFF_UQ), NQ, a.in[9] + l * 256, scr, r, lane, MapUq()); continue; } r -= I_UQ;
        if (r < I_UKV) { transpose_item(a.in[12] + (size_t)l * 128 * NKV, 128, NKV, wptr(ws_, l, OFF_UKV), NKV, a.in[11] + l * 128, scr, r, lane, MapId()); continue; } r -= I_UKV;
        transpose_item(a.in[16] + (size_t)l * DM * DM, DM, DM, wptr(ws_, l, OFF_OUT), DM, nullptr, scr, r, lane, MapId());
    }
    for (int idx = (gw * 64 + lane); idx < 2 * 4 * 128 * 128 / 4; idx += NGW * 64) {
        const int l = idx / (4 * 128 * 128 / 4), e = idx % (4 * 128 * 128 / 4);
        const f32x4 v = *(const f32x4*)(a.in[14] + (size_t)l * 65536 + 4 * e);
        u32x2 o; o.x = cvtpk(v[0], v[1]); o.y = cvtpk(v[2], v[3]);
        *(u32x2*)(wptr(ws_, l, OFF_GWS) + 4 * e) = o;
    }
}

constexpr int RP = 4;
__device__ __forceinline__ void wave_sum4(float (&s)[RP], int lane) {
#pragma unroll
    for (int o = 1; o < 64; o <<= 1) {
        float t[RP];
#pragma unroll
        for (int k = 0; k < RP; ++k) t[k] = shflx(s[k], o, lane);
#pragma unroll
        for (int k = 0; k < RP; ++k) s[k] += t[k];
    }
}
__device__ __forceinline__ void bf8_to_f32(const u32x4 w, f32x4& a, f32x4& b) { a = (f32x4){bflo(w.x), bfhi(w.x), bflo(w.y), bfhi(w.y)}; b = (f32x4){bflo(w.z), bfhi(w.z), bflo(w.w), bfhi(w.w)}; }
__device__ __forceinline__ void row_pass(const float* __restrict__ xf, const bf16_t* xb, const bf16_t* __restrict__ H, float coef, const float* __restrict__ gpost,
                                         float* __restrict__ xout, bf16_t* XB, float* SC, int gw, int NGW, int lane) {
    f32x4 gp[2][2];
#pragma unroll
    for (int j = 0; j < 2; ++j)
#pragma unroll
        for (int q = 0; q < 2; ++q) gp[j][q] = H ? *(const f32x4*)(gpost + 8 * lane + 512 * j + 4 * q) * coef : (f32x4){0.f, 0.f, 0.f, 0.f};
#define RP_ROW0(rit_) ((NGW * RP == 8192) ? (32 * (4 * (((rit_) >> 13) & 1) + ((((rit_) & 8191) >> 8) >> 3)) + 8 * (3 - ((rit_) >> 14)) + ((((rit_) & 8191) >> 8) & 7)) * 256 + ((rit_) & 255) : (rit_))
    if (xf && !H && XB && !xout) {
        f32x4 c[RP][2][2];
        int rit = gw * RP, row0 = RP_ROW0(rit);
#pragma unroll
        for (int k = 0; k < RP; ++k)
#pragma unroll
            for (int j = 0; j < 2; ++j)
#pragma unroll
                for (int q = 0; q < 2; ++q) c[k][j][q] = *(const f32x4*)(xf + (size_t)(row0 + k) * DM + 8 * lane + 512 * j + 4 * q);
#pragma unroll 1
        for (; rit < T_TOK; rit += NGW * RP) {
            const int rnx = rit + NGW * RP; const int row1 = (rnx < T_TOK) ? RP_ROW0(rnx) : row0;
            f32x4 n[RP][2][2];
#pragma unroll
            for (int k = 0; k < RP; ++k)
#pragma unroll
                for (int j = 0; j < 2; ++j)
#pragma unroll
                    for (int q = 0; q < 2; ++q) n[k][j][q] = *(const f32x4*)(xf + (size_t)(row1 + k) * DM + 8 * lane + 512 * j + 4 * q);
            float ss[RP];
#pragma unroll
            for (int k = 0; k < RP; ++k) { ss[k] = 0.f;
#pragma unroll
                for (int j = 0; j < 2; ++j) ss[k] += sumsq4(c[k][j][0]) + sumsq4(c[k][j][1]); }
            wave_sum4(ss, lane);
#pragma unroll
            for (int k = 0; k < RP; ++k) { const float ms = ss[k] * (1.0f / DM) + EPS; const float rstd = 1.0f / sqrtf(ms);
#pragma unroll
                for (int j = 0; j < 2; ++j) *(u32x4*)(XB + (size_t)(row0 + k) * DM + 8 * lane + 512 * j) = pack8(c[k][j][0] * rstd, c[k][j][1] * rstd);
                if (lane == 0) SC[row0 + k] = sqrtf(ms); }
#pragma unroll
            for (int k = 0; k < RP; ++k)
#pragma unroll
                for (int j = 0; j < 2; ++j)
#pragma unroll
                    for (int q = 0; q < 2; ++q) c[k][j][q] = n[k][j][q];
            row0 = row1;
        }
        return;
    }
    if (!xf && H) {
        u32x4 xw[RP][2], hw[RP][2]; float scv[RP];
        int rit = gw * RP, row0 = RP_ROW0(rit);
#pragma unroll
        for (int k = 0; k < RP; ++k) { scv[k] = SC[row0 + k];
#pragma unroll
            for (int j = 0; j < 2; ++j) { xw[k][j] = *(const u32x4*)(xb + (size_t)(row0 + k) * DM + 8 * lane + 512 * j); hw[k][j] = *(const u32x4*)(H + (size_t)(row0 + k) * DM + 8 * lane + 512 * j); } }
#pragma unroll 1
        for (; rit < T_TOK; rit += NGW * RP) {
            const int rnx = rit + NGW * RP; const bool more = rnx < T_TOK; const int row1 = more ? RP_ROW0(rnx) : row0;
            u32x4 xn_[RP][2], hn_[RP][2]; float scn[RP];
#pragma unroll
            for (int k = 0; k < RP; ++k) { scn[k] = SC[row1 + k];
#pragma unroll
                for (int j = 0; j < 2; ++j) { xn_[k][j] = *(const u32x4*)(xb + (size_t)(row1 + k) * DM + 8 * lane + 512 * j); hn_[k][j] = *(const u32x4*)(H + (size_t)(row1 + k) * DM + 8 * lane + 512 * j); } }
            f32x4 v[RP][2][2]; float ss[RP];
#pragma unroll
            for (int k = 0; k < RP; ++k) { ss[k] = 0.f;
#pragma unroll
                for (int j = 0; j < 2; ++j) { f32x4 h0, h1; bf8_to_f32(hw[k][j], h0, h1); ss[k] += sumsq4(h0) + sumsq4(h1); } }
            wave_sum4(ss, lane);
#pragma unroll
            for (int k = 0; k < RP; ++k) { const float rstd = 1.0f / sqrtf(ss[k] * (1.0f / DM) + EPS);
#pragma unroll
                for (int j = 0; j < 2; ++j) { f32x4 h0, h1, x0, x1; bf8_to_f32(hw[k][j], h0, h1); bf8_to_f32(xw[k][j], x0, x1);
                    v[k][j][0] = x0 * scv[k] + h0 * rstd * gp[j][0]; v[k][j][1] = x1 * scv[k] + h1 * rstd * gp[j][1]; } }
            if (xout) {
#pragma unroll
                for (int k = 0; k < RP; ++k)
#pragma unroll
                    for (int j = 0; j < 2; ++j)
#pragma unroll
                        for (int q = 0; q < 2; ++q) *(f32x4*)(xout + (size_t)(row0 + k) * DM + 8 * lane + 512 * j + 4 * q) = v[k][j][q];
            }
            if (XB) {
#pragma unroll
                for (int k = 0; k < RP; ++k) { ss[k] = 0.f;
#pragma unroll
                    for (int j = 0; j < 2; ++j) ss[k] += sumsq4(v[k][j][0]) + sumsq4(v[k][j][1]); }
                wave_sum4(ss, lane);
#pragma unroll
                for (int k = 0; k < RP; ++k) { const float ms = ss[k] * (1.0f / DM) + EPS; const float rstd = 1.0f / sqrtf(ms);
#pragma unroll
                    for (int j = 0; j < 2; ++j) *(u32x4*)(XB + (size_t)(row0 + k) * DM + 8 * lane + 512 * j) = pack8(v[k][j][0] * rstd, v[k][j][1] * rstd);
                    if (lane == 0) SC[row0 + k] = sqrtf(ms); }
            }
#pragma unroll
            for (int k = 0; k < RP; ++k) { scv[k] = scn[k];
#pragma unroll
                for (int j = 0; j < 2; ++j) { xw[k][j] = xn_[k][j]; hw[k][j] = hn_[k][j]; } }
            row0 = row1;
        }
        return;
    }
#pragma unroll 1
    for (int rit = gw * RP; rit < T_TOK; rit += NGW * RP) {
        int row0 = rit;
        if (NGW * RP == 8192) { const int j = rit >> 13, li = rit & 8191, pl = li >> 8; row0 = (32 * (4 * (j & 1) + (pl >> 3)) + 8 * (3 - (j >> 1)) + (pl & 7)) * 256 + (li & 255); }
        f32x4 v[RP][2][2]; u32x4 hw[RP][2];
        if (xf) {
#pragma unroll
            for (int k = 0; k < RP; ++k)
#pragma unroll
                for (int j = 0; j < 2; ++j)
#pragma unroll
                    for (int q = 0; q < 2; ++q) v[k][j][q] = *(const f32x4*)(xf + (size_t)(row0 + k) * DM + 8 * lane + 512 * j + 4 * q);
        } else {
#pragma unroll
            for (int k = 0; k < RP; ++k) { const float sc = SC[row0 + k];
#pragma unroll
                for (int j = 0; j < 2; ++j) { const u32x4 w = *(const u32x4*)(xb + (size_t)(row0 + k) * DM + 8 * lane + 512 * j); bf8_to_f32(w, v[k][j][0], v[k][j][1]); v[k][j][0] = v[k][j][0] * sc; v[k][j][1] = v[k][j][1] * sc; } }
        }
        if (H) {
#pragma unroll
            for (int k = 0; k < RP; ++k)
#pragma unroll
                for (int j = 0; j < 2; ++j) hw[k][j] = *(const u32x4*)(H + (size_t)(row0 + k) * DM + 8 * lane + 512 * j);
            float ss[RP];
#pragma unroll
            for (int k = 0; k < RP; ++k) { ss[k] = 0.f;
#pragma unroll
                for (int j = 0; j < 2; ++j) { f32x4 h0, h1; bf8_to_f32(hw[k][j], h0, h1); ss[k] += sumsq4(h0) + sumsq4(h1); } }
            wave_sum4(ss, lane);
#pragma unroll
            for (int k = 0; k < RP; ++k) { const float rstd = 1.0f / sqrtf(ss[k] * (1.0f / DM) + EPS);
#pragma unroll
                for (int j = 0; j < 2; ++j) { f32x4 h0, h1; bf8_to_f32(hw[k][j], h0, h1); v[k][j][0] = v[k][j][0] + h0 * rstd * gp[j][0]; v[k][j][1] = v[k][j][1] + h1 * rstd * gp[j][1]; } }
        }
        if (xout) {
#pragma unroll
            for (int k = 0; k < RP; ++k)
#pragma unroll
                for (int j = 0; j < 2; ++j)
#pragma unroll
                    for (int q = 0; q < 2; ++q) *(f32x4*)(xout + (size_t)(row0 + k) * DM + 8 * lane + 512 * j + 4 * q) = v[k][j][q];
        }
        if (XB) {
            float ss[RP];
#pragma unroll
            for (int k = 0; k < RP; ++k) { ss[k] = 0.f;
#pragma unroll
                for (int j = 0; j < 2; ++j) ss[k] += sumsq4(v[k][j][0]) + sumsq4(v[k][j][1]); }
            wave_sum4(ss, lane);
#pragma unroll
            for (int k = 0; k < RP; ++k) { const float ms = ss[k] * (1.0f / DM) + EPS; const float rstd = 1.0f / sqrtf(ms);
#pragma unroll
                for (int j = 0; j < 2; ++j) *(u32x4*)(XB + (size_t)(row0 + k) * DM + 8 * lane + 512 * j) = pack8(v[k][j][0] * rstd, v[k][j][1] * rstd);
                if (lane == 0) SC[row0 + k] = sqrtf(ms); }
        }
    }
}

__device__ __forceinline__ void unpack8(const u32x4 w, float (&o)[8]) { o[0] = bflo(w.x); o[1] = bfhi(w.x); o[2] = bflo(w.y); o[3] = bfhi(w.y); o[4] = bflo(w.z); o[5] = bfhi(w.z); o[6] = bflo(w.w); o[7] = bfhi(w.w); }
__device__ __forceinline__ void conv_phase(const bf16_t* __restrict__ ZC, const float* __restrict__ cw, const float* __restrict__ cb, bf16_t* __restrict__ Y, int gtid, int gthreads) {
    for (int item = gtid; item < (T_TOK / 16) * 32; item += gthreads) {
        const int ch = item & 31, rb = item >> 5, t0 = rb * 16, c0 = ch * 8;
        float w0[8], w1[8], w2[8], bb[8];
#pragma unroll
        for (int e = 0; e < 8; ++e) { w0[e] = cw[c0 + e]; w1[e] = cw[256 + c0 + e]; w2[e] = cw[512 + c0 + e]; bb[e] = cb[c0 + e]; }
        float zp[8], zc[8], zn[8];
        {
            if ((t0 & (SEQ - 1)) != 0) { float x[8], g[8]; unpack8(*(const u32x4*)(ZC + (size_t)(t0 - 1) * 768 + c0), x); unpack8(*(const u32x4*)(ZC + (size_t)(t0 - 1) * 768 + 512 + c0), g);
#pragma unroll
                for (int e = 0; e < 8; ++e) zp[e] = x[e] * g[e]; }
            else {
#pragma unroll
                for (int e = 0; e < 8; ++e) zp[e] = 0.f; }
            float x[8], g[8]; unpack8(*(const u32x4*)(ZC + (size_t)t0 * 768 + c0), x); unpack8(*(const u32x4*)(ZC + (size_t)t0 * 768 + 512 + c0), g);
#pragma unroll
            for (int e = 0; e < 8; ++e) zc[e] = x[e] * g[e];
        }
        for (int i = 0; i < 16; ++i) {
            const int t = t0 + i;
            if (((t + 1) & (SEQ - 1)) != 0) { float x[8], g[8]; unpack8(*(const u32x4*)(ZC + (size_t)(t + 1) * 768 + c0), x); unpack8(*(const u32x4*)(ZC + (size_t)(t + 1) * 768 + 512 + c0), g);
#pragma unroll
                for (int e = 0; e < 8; ++e) zn[e] = x[e] * g[e]; }
            else {
#pragma unroll
                for (int e = 0; e < 8; ++e) zn[e] = 0.f; }
            float gbv[8]; unpack8(*(const u32x4*)(ZC + (size_t)t * 768 + 256 + c0), gbv);
            float o[8];
#pragma unroll
            for (int e = 0; e < 8; ++e) o[e] = gbv[e] * (w0[e] * zp[e] + w1[e] * zc[e] + w2[e] * zn[e] + bb[e]);
            u32x4 w; w.x = cvtpk(o[0], o[1]); w.y = cvtpk(o[2], o[3]); w.z = cvtpk(o[4], o[5]); w.w = cvtpk(o[6], o[7]);
            *(u32x4*)(Y + (size_t)t * DM + c0) = w;
#pragma unroll
            for (int e = 0; e < 8; ++e) { zp[e] = zc[e]; zc[e] = zn[e]; }
        }
    }
}

__device__ __forceinline__ int lane_id() { int l; asm volatile("v_mbcnt_lo_u32_b32 %0, -1, 0\n\tv_mbcnt_hi_u32_b32 %0, -1, %0" : "=v"(l)); return l; }
#define MFMA32(a, b, c) __builtin_amdgcn_mfma_f32_32x32x16_bf16((a), (b), (c), 0, 0, 0)
__device__ __forceinline__ int crow(int i, int h) { return (i & 3) + 8 * (i >> 2) + 4 * h; }
template <int S> __device__ __forceinline__ bf16x8 packstep(const f32x16& x) {
    u32x4 p; p.x = cvtpk(x[8 * S], x[8 * S + 1]); p.y = cvtpk(x[8 * S + 2], x[8 * S + 3]); p.z = cvtpk(x[8 * S + 4], x[8 * S + 5]); p.w = cvtpk(x[8 * S + 6], x[8 * S + 7]);
    return __builtin_bit_cast(bf16x8, p);
}
typedef short v4i16_t __attribute__((ext_vector_type(4)));
__device__ __forceinline__ s16x4 tr_read(LAS unsigned char* p) { return __builtin_bit_cast(s16x4, __builtin_amdgcn_ds_read_tr16_b64_v4i16((LAS v4i16_t*)p)); }

constexpr int GM_PITCH = 272;
__device__ __forceinline__ void gmlp_phase(LAS unsigned char* lds, const bf16_t* __restrict__ U, const bf16_t* __restrict__ V, const float* __restrict__ PV, const float* __restrict__ gng,
                                           const bf16_t* __restrict__ WS, const float* __restrict__ bias, bf16_t* __restrict__ Y, int gw, int NGW, int wave, int lane) {
    LAS unsigned char* vt = lds + wave * (64 * GM_PITCH);
    const int r = lane & 31, hh = lane >> 5;
    for (int unit = gw; unit < 2048; unit += NGW) {
        const int g = unit & 3, bc = unit >> 2; const size_t row0 = (size_t)bc * 128;
        {
            const int ch = lane & 7; float gn[8];
#pragma unroll
            for (int e = 0; e < 8; ++e) gn[e] = gng[g * 64 + ch * 8 + e];
#pragma unroll 4
            for (int it = 0; it < 16; ++it) {
                const int q = it * 8 + (lane >> 3);
                const f32x4 p = *(const f32x4*)(PV + (row0 + q) * 4);
                const float rstd = 1.0f / sqrtf(((p[0] + p[1]) + (p[2] + p[3])) * (1.0f / 256.0f) + EPS);
                float x[8]; unpack8(*(const u32x4*)(V + (row0 + q) * 256 + g * 64 + ch * 8), x);
#pragma unroll
                for (int e = 0; e < 8; ++e) *(LAS unsigned short*)(vt + (ch * 8 + e) * GM_PITCH + q * 2) = f2bf(x[e] * rstd * gn[e]);
            }
        }
        asm volatile("s_waitcnt lgkmcnt(0)" ::: "memory");
        bf16x8 bfr[2][8];
#pragma unroll
        for (int dt = 0; dt < 2; ++dt)
#pragma unroll
            for (int ks = 0; ks < 8; ++ks) bfr[dt][ks] = *(LAS bf16x8*)(vt + (32 * dt + r) * GM_PITCH + (16 * ks + 8 * hh) * 2);
#pragma unroll 1
        for (int pt = 0; pt < 4; ++pt) {
            f32x16 o0 = {}, o1 = {};
            const bf16_t* wp = WS + ((size_t)(g * 128 + 32 * pt + r)) * 128 + 8 * hh;
#pragma unroll
            for (int ks = 0; ks < 8; ++ks) { const bf16x8 af = *(const bf16x8*)(wp + 16 * ks); o0 = MFMA32(bfr[0][ks], af, o0); o1 = MFMA32(bfr[1][ks], af, o1); }
            { const int pp = 32 * pt + r; const float bs = bias[g * 128 + pp];
              const bf16_t* up = U + (row0 + pp) * 256 + g * 64 + 4 * hh; bf16_t* yp = Y + (row0 + pp) * DM + 768 + g * 64 + 4 * hh;
#pragma unroll
              for (int q4 = 0; q4 < 4; ++q4) {
                  const u32x2 u0 = *(const u32x2*)(up + 8 * q4), u1 = *(const u32x2*)(up + 32 + 8 * q4);
                  u32x2 w0, w1;
                  w0.x = cvtpk(bflo(u0.x) * (o0[4 * q4] + bs), bfhi(u0.x) * (o0[4 * q4 + 1] + bs)); w0.y = cvtpk(bflo(u0.y) * (o0[4 * q4 + 2] + bs), bfhi(u0.y) * (o0[4 * q4 + 3] + bs));
                  w1.x = cvtpk(bflo(u1.x) * (o1[4 * q4] + bs), bfhi(u1.x) * (o1[4 * q4 + 1] + bs)); w1.y = cvtpk(bflo(u1.y) * (o1[4 * q4 + 2] + bs), bfhi(u1.y) * (o1[4 * q4 + 3] + bs));
                  *(u32x2*)(yp + 8 * q4) = w0; *(u32x2*)(yp + 32 + 8 * q4) = w1; } }
        }
        asm volatile("s_waitcnt lgkmcnt(0)" ::: "memory");
    }
}

__device__ __forceinline__ float xhalf_max(float m) { float a = m, b = m; asm volatile("v_nop\n\tv_nop\n\tv_permlane32_swap_b32 %0, %1" : "+v"(a), "+v"(b)); return fmaxf(a, b); }
__device__ __forceinline__ float xhalf_sum(float m) { float a = m, b = m; asm volatile("v_nop\n\tv_nop\n\tv_permlane32_swap_b32 %0, %1" : "+v"(a), "+v"(b)); return a + b; }
constexpr int AT_KP = 208, AT_VP = 144, AT_KB = 64 * AT_KP, AT_VB = 64 * AT_VP, AT_STAGE = AT_KB + AT_VB;
constexpr int AT_WSF = 2 * AT_STAGE, AT_QOFF = AT_WSF + 8 * 64 * 4, AT_QW = 64 * 192;
static_assert(AT_QOFF + 8 * AT_QW <= LDS_BYTES - 64, "attention LDS map");
#define FMAX2(a, b) __builtin_amdgcn_fmed3f((a), (b), __builtin_inff())
#define AT_SOFTMAX(s0, s1, m_run, l_run, oA, oB, wsfp) do { \
        float tmax = FMAX2(s0[0], s1[0]); \
        _Pragma("unroll") for (int i = 1; i < 16; ++i) tmax = FMAX2(tmax, FMAX2(s0[i], s1[i])); \
        tmax = xhalf_max(tmax); \
        if (__any(tmax > m_run + 8.0f)) { \
            const float m_new = fmaxf(m_run, tmax); const float f = __builtin_amdgcn_exp2f(m_run - m_new); m_run = m_new; l_run *= f; \
            if (hh == 0) (wsfp)[r] = f; \
            asm volatile("s_waitcnt lgkmcnt(0)" ::: "memory"); \
            _Pragma("unroll") for (int i = 0; i < 16; ++i) { const float fi = ((wsfp) + 4 * hh)[(i & 3) + 8 * (i >> 2)]; oA[i] *= fi; oB[i] *= fi; } \
        } \
        float ps = 0.f; \
        _Pragma("unroll") for (int i = 0; i < 16; ++i) { s0[i] = __builtin_amdgcn_exp2f(s0[i] - m_run); s1[i] = __builtin_amdgcn_exp2f(s1[i] - m_run); ps += s0[i] + s1[i]; } \
        l_run += ps; } while (0)

__device__ __forceinline__ void attn_phase(LAS unsigned char* lds, const bf16_t* __restrict__ Q, const bf16_t* __restrict__ KV, const bf16_t* __restrict__ KR, bf16_t* __restrict__ Y, int vcu, int G, const int tid) {
    const int lane = tid & 63, wid = __builtin_amdgcn_readfirstlane(tid >> 6), r = lane & 31, hh = lane >> 5;
    const int srow = tid >> 3, sch = tid & 7, rrow = (tid >> 2) & 63, rch = tid & 3;
    LAS float* wsf = (LAS float*)(lds + AT_WSF) + wid * 64;
    LAS unsigned char* qimg = lds + AT_QOFF + wid * AT_QW;
    const int i16 = lane & 15, tq = i16 >> 2, tp = i16 & 3, blk = (lane >> 4) & 1;
    const int voff = (4 * hh + tq) * AT_VP + blk * 32 + tp * 8;
    const int qsw = (r >> 2) & 3;
    for (int bh = vcu; bh < 256; bh += G) {
        const int b = bh >> 3, h = bh & 7; const size_t rowbase = (size_t)b * SEQ;
        const bf16_t* kvsrc = KV + (rowbase + srow) * NKV + h * 128 + sch * 8;
        const bf16_t* krsrc = KR + (rowbase + rrow) * 32 + rch * 8;
#pragma unroll 1
        for (int qb = 0; qb < 4; ++qb) {
            {
                const bf16_t* qsrc = Q + (rowbase + qb * 512 + wid * 64 + lane) * NQ + h * 96;
                const int key = (lane >> 2) & 3;
#pragma unroll
                for (int bq = 0; bq < 4; ++bq) { LAS unsigned char* dst = qimg + lane * 192 + ((bq ^ key) << 4);
#pragma unroll
                    for (int aq = 0; aq < 3; ++aq) *(LAS u32x4*)(dst + 64 * aq) = *(const u32x4*)(qsrc + (4 * aq + bq) * 8); }
            }
            u32x4 gk = *(const u32x4*)(kvsrc), gv = *(const u32x4*)(kvsrc + 64), gr = (u32x4){0u, 0u, 0u, 0u};
            if (tid < 256) gr = *(const u32x4*)(krsrc);
            float ma = -1e30f, la = 0.f, mb = -1e30f, lb = 0.f; f32x16 oa0 = {}, oa1 = {}, ob0 = {}, ob1 = {};
#pragma unroll 1
            for (int t = 0; t < SEQ / 64; ++t) {
                LAS unsigned char* kb = lds + (t & 1) * AT_STAGE; LAS unsigned char* vb = kb + AT_KB;
                *(LAS u32x4*)(kb + srow * AT_KP + sch * 16) = gk;
                *(LAS u32x4*)(vb + srow * AT_VP + sch * 16) = gv;
                if (tid < 256) *(LAS u32x4*)(kb + rrow * AT_KP + 128 + rch * 16) = gr;
                __syncthreads();
                if (t + 1 < SEQ / 64) { const size_t adv = (size_t)(t + 1) * 64;
                    gk = *(const u32x4*)(kvsrc + adv * NKV); gv = *(const u32x4*)(kvsrc + adv * NKV + 64);
                    if (tid < 256) gr = *(const u32x4*)(krsrc + adv * 32); }
                f32x16 sa0 = {}, sa1 = {}, sb0 = {}, sb1 = {};
#pragma unroll
                for (int ks = 0; ks < 6; ++ks) {
                    const bf16x8 k0 = *(LAS bf16x8*)(kb + r * AT_KP + ks * 32 + hh * 16);
                    const bf16x8 k1 = *(LAS bf16x8*)(kb + (32 + r) * AT_KP + ks * 32 + hh * 16);
                    const int qc = ((2 * ks + hh) ^ qsw) << 4;
                    const bf16x8 qa = *(LAS bf16x8*)(qimg + r * 192 + qc);
                    const bf16x8 qb2 = *(LAS bf16x8*)(qimg + (32 + r) * 192 + qc);
                    sa0 = MFMA32(k0, qa, sa0); sa1 = MFMA32(k1, qa, sa1);
                    sb0 = MFMA32(k0, qb2, sb0); sb1 = MFMA32(k1, qb2, sb1);
                }
                AT_SOFTMAX(sa0, sa1, ma, la, oa0, oa1, wsf);
                const bf16x8 pa00 = packstep<0>(sa0), pa01 = packstep<1>(sa0), pa10 = packstep<0>(sa1), pa11 = packstep<1>(sa1);
                AT_SOFTMAX(sb0, sb1, mb, lb, ob0, ob1, wsf + 32);
                const bf16x8 pb00 = packstep<0>(sb0), pb01 = packstep<1>(sb0), pb10 = packstep<0>(sb1), pb11 = packstep<1>(sb1);
#define PVSTEP(pa, pb, kv0) do { \
                    const s16x4 l0 = tr_read(vb + (kv0) * AT_VP + voff), h0 = tr_read(vb + ((kv0) + 8) * AT_VP + voff); \
                    const s16x4 l1 = tr_read(vb + (kv0) * AT_VP + voff + 64), h1 = tr_read(vb + ((kv0) + 8) * AT_VP + voff + 64); \
                    const bf16x8 v0 = __builtin_shufflevector(l0, h0, 0, 1, 2, 3, 4, 5, 6, 7), v1 = __builtin_shufflevector(l1, h1, 0, 1, 2, 3, 4, 5, 6, 7); \
                    oa0 = MFMA32(pa, v0, oa0); oa1 = MFMA32(pa, v1, oa1); ob0 = MFMA32(pb, v0, ob0); ob1 = MFMA32(pb, v1, ob1); } while (0)
                PVSTEP(pa00, pb00, 0); PVSTEP(pa01, pb01, 16); PVSTEP(pa10, pb10, 32); PVSTEP(pa11, pb11, 48);
#undef PVSTEP
            }
            const float lta = xhalf_sum(la), ltb = xhalf_sum(lb);
            if (hh == 0) { wsf[r] = 1.0f / lta; wsf[32 + r] = 1.0f / ltb; }
            asm volatile("s_waitcnt lgkmcnt(0)" ::: "memory");
            bf16_t* yp = Y + (rowbase + qb * 512 + wid * 64 + 4 * hh) * DM + 256 + h * 64 + r;
            asm volatile("" : "+v"(yp));
            LAS float* wsfh = wsf + 4 * hh;
#pragma unroll
            for (int i = 0; i < 16; ++i) { const int q = (i & 3) + 8 * (i >> 2); const float fa = wsfh[q], fb = wsfh[32 + q];
                yp[(size_t)q * DM] = f2bf(oa0[i] * fa); yp[(size_t)q * DM + 32] = f2bf(oa1[i] * fa);
                yp[(size_t)(32 + q) * DM] = f2bf(ob0[i] * fb); yp[(size_t)(32 + q) * DM + 32] = f2bf(ob1[i] * fb); }
            __syncthreads();
        }
    }
}

#define XB_TMO      128
#define XB_XCNT(j)  (256  + 64 * (j))
#define XB_XSUB(j)  (1280 + 64 * (j))
#define XB_XGEN(j)  (2304 + 64 * (j))
#define XB_TOP      3328
#define XB_TOPGEN   3392
#define XCD_BAR_WORDS 3456
#define XB_SPIN_CAP (1u << 18)

__device__ __forceinline__ unsigned xb_ld(unsigned* p)              { return __hip_atomic_load(p, __ATOMIC_RELAXED, __HIP_MEMORY_SCOPE_AGENT); }
__device__ __forceinline__ unsigned xb_add(unsigned* p, unsigned v) { return __hip_atomic_fetch_add(p, v, __ATOMIC_RELAXED, __HIP_MEMORY_SCOPE_AGENT); }
__device__ __forceinline__ unsigned xb_xcc_id() { return (unsigned)__builtin_amdgcn_s_getreg((3 << 11) | 20) & 0xFu; }
#define XB_SPIN(cond, bar) do { unsigned _sp = 0; while (cond) { __builtin_amdgcn_s_sleep(1); \
    if ((++_sp & 255u) == 0u) { if (xb_ld(&(bar)[XB_TMO])) break; if (_sp > XB_SPIN_CAP) { atomicAdd(&(bar)[XB_TMO], 1u); break; } } } } while (0)

struct XcdBarrier {
    unsigned* bar; unsigned x;
    volatile LAS unsigned* st;
};

__device__ __forceinline__ XcdBarrier xcd_barrier_post(unsigned* bar, volatile LAS unsigned* st) {
    XcdBarrier b; b.bar = bar; b.x = xb_xcc_id(); b.st = st;
    if (threadIdx.x == 0) (void)xb_add(&bar[XB_XCNT(b.x)], 1u);
    return b;
}
__device__ __forceinline__ void xcd_barrier_complete(unsigned* bar, unsigned x, unsigned& nloc, unsigned& nx) {
    const unsigned G = gridDim.x * gridDim.y * gridDim.z;
    unsigned sum, cnt, mine, sp = 0u;
    for (;;) {
        sum = 0u; cnt = 0u; mine = 0u;
#pragma unroll
        for (unsigned j = 0; j < 16; ++j) { const unsigned c = xb_ld(&bar[XB_XCNT(j)]); sum += c; cnt += (c > 0u) ? 1u : 0u; mine = (j == x) ? c : mine; }
        if (sum == G) break;
        __builtin_amdgcn_s_sleep(1);
        if ((++sp & 255u) == 0u) { if (xb_ld(&bar[XB_TMO])) break; if (sp > XB_SPIN_CAP) { atomicAdd(&bar[XB_TMO], 1u); break; } }
    }
    nloc = mine > 0u ? mine : 1u; nx = cnt > 0u ? cnt : 1u;
}

__device__ __forceinline__ void xcd_barrier(const XcdBarrier& b) {
    asm volatile("s_waitcnt vmcnt(0)" ::: "memory");
    __syncthreads();
    if (threadIdx.x == 0) {
        unsigned* bar = b.bar;
        __builtin_amdgcn_s_waitcnt(0);
        unsigned nloc = b.st[0], nx = b.st[1];
        if (nloc == 0u) { xcd_barrier_complete(bar, b.x, nloc, nx); b.st[0] = nloc; b.st[1] = nx; }
        const unsigned old = xb_add(&bar[XB_XSUB(b.x)], 1u);
        const unsigned gen = old / nloc;
        if (old + 1u == (gen + 1u) * nloc) {
            __builtin_amdgcn_fence(__ATOMIC_RELEASE, "agent");
            asm volatile("s_waitcnt vmcnt(0)" ::: "memory");
            const unsigned og = xb_add(&bar[XB_TOP], 1u);
            const unsigned tg = og / nx;
            if (og + 1u == (tg + 1u) * nx) xb_add(&bar[XB_TOPGEN], 1u);
            else XB_SPIN(xb_ld(&bar[XB_TOPGEN]) == tg, bar);
            __builtin_amdgcn_fence(__ATOMIC_ACQUIRE, "agent");
            xb_add(&bar[XB_XGEN(b.x)], 1u);
            asm volatile("s_waitcnt vmcnt(0)" ::: "memory");
        } else {
            XB_SPIN(xb_ld(&bar[XB_XGEN(b.x)]) == gen, bar);
            __builtin_amdgcn_fence(__ATOMIC_ACQUIRE, "agent");
            asm volatile("s_waitcnt vmcnt(0)" ::: "memory");
        }
    }
    __syncthreads();
}


#ifndef REP_CONV
#define REP_CONV 1
#endif
#ifndef REP_GMLP
#define REP_GMLP 1
#endif
#ifndef REP_PRO
#define REP_PRO 1
#endif
#ifndef REP_RP
#define REP_RP 1
#endif
#ifndef REP_GU
#define REP_GU 1
#endif
#ifndef REP_DN
#define REP_DN 1
#endif
#ifndef REP_WIN
#define REP_WIN 1
#endif
#ifndef REP_MIX2
#define REP_MIX2 1
#endif
#define GEMM_CALL(EpiT, E, Aptr, Bptr, Mv, Nv, Kv) do { pg8::Gemm g_{(Aptr), (Bptr), (Mv), (Nv), (Kv)}; pg8::StaticOrder S_; S_.init((Mv), (Nv), G, (int)blockIdx.x); \
        int l_o_ = lane_id(); asm volatile("" : "+v"(l_o_)); pg8::gemm_phase<EpiT, pg8::StaticOrder, true, true>(lds, g_, S_, (E), wave * 64 + l_o_); __syncthreads(); } while (0)

__global__ void __launch_bounds__(NTHR, 2) mk_fwd(Args a) {
    extern __shared__ __attribute__((aligned(16))) unsigned char lds_raw[];
    LAS unsigned char* lds = (LAS unsigned char*)lds_raw;
    cg::grid_group grid = cg::this_grid();
    const int wave = __builtin_amdgcn_readfirstlane((int)threadIdx.x >> 6);
    const int G = gridDim.x, bx = blockIdx.x, vcu = (G % 8 == 0) ? (bx % 8) * (G / 8) + bx / 8 : bx;
    const int gw = vcu * NWAVES + wave, NGW = G * NWAVES, gthreads = G * NTHR;
    unsigned char* const ws_k = a.ws;
#define rope ((float*)(ws + WS_ROPE))
#define PQ ((float*)(ws + WS_PQ))
#define PKV ((float*)(ws + WS_PKV))
#define PV ((float*)(ws + WS_PV))
#define RSv ((float*)(ws + WS_RS))
#define XN ((bf16_t*)(ws + WS_XN))
#define ACT ((bf16_t*)(ws + WS_ACT))
#define ZC ((bf16_t*)(ws + WS_ZC))
#define CQ ((bf16_t*)(ws + WS_CQ))
#define Ub ((bf16_t*)(ws + WS_U))
#define Vb ((bf16_t*)(ws + WS_V))
#define CKV ((bf16_t*)(ws + WS_CKV))
#define KR ((bf16_t*)(ws + WS_KR))
#define Qb ((bf16_t*)(ws + WS_Q))
#define KVb ((bf16_t*)(ws + WS_KV))
#define Yb ((bf16_t*)(ws + WS_Y))
#define Hb ((bf16_t*)(ws + WS_H))
    float* X = a.out;
    volatile LAS unsigned* misc = (volatile LAS unsigned*)(lds + LDS_BYTES - 64);
    if (threadIdx.x < 2) misc[threadIdx.x] = 0u;
    if (bx == 0) { for (int i = threadIdx.x; i < XCD_BAR_WORDS; i += NTHR) ((unsigned*)(a.ws + 65536))[i] = 0u; }
    XcdBarrier xbar; xbar.bar = (unsigned*)(a.ws + 65536); xbar.x = 0; xbar.st = misc;
    int ph = 0;
    const int lo = a.ph_lo, hi = a.ph_hi;
#define RUN (ph >= lo && ph < hi)
#define OPAQUE_IDS unsigned long long wsv_ = (unsigned long long)ws_k; asm volatile("" : "+s"(wsv_)); unsigned char* ws = (unsigned char*)(__attribute__((address_space(1))) unsigned char*)wsv_; int lane_o_ = lane_id(); asm volatile("" : "+v"(lane_o_)); const int tid = wave * 64 + lane_o_; const int lane = tid & 63, gtid = bx * NTHR + tid; (void)lane; (void)gtid;
#define SEAM do { if (ph >= lo && ph + 1 < hi) { if (ph == 0) { grid.sync(); xbar = xcd_barrier_post((unsigned*)(a.ws + 65536), misc); } else xcd_barrier(xbar); } ++ph; } while (0)

    if (RUN) { OPAQUE_IDS
#ifndef NO_PRO
        _Pragma("unroll 1") for (int rr_ = 0; rr_ < REP_PRO; ++rr_) prologue_weights(a, ws, lds, gw, NGW, wave, lane);
#endif
        rope_table(rope, gtid, gthreads);
        row_pass(a.in[0], nullptr, nullptr, 0.f, nullptr, nullptr, XN, RSv, gw, NGW, lane);
    }
    SEAM;

#pragma unroll 1
    for (int sb = 0; sb < 6; ++sb) {
        const int l = sb / 3, kind = sb % 3;
        if (kind != 1) {
            #ifndef NO_GU
            _Pragma("unroll 1") for (int rep_ = 0; rep_ < REP_GU; ++rep_)
            if (RUN) { OPAQUE_IDS EpiSwiGLU E{ACT, RSv}; GEMM_CALL(EpiSwiGLU, E, XN, wptr(ws, l, kind == 0 ? OFF_GU1 : OFF_GU2), T_TOK, NGU, DM); }
#endif
            SEAM;
            #ifndef NO_DN
            _Pragma("unroll 1") for (int rep_ = 0; rep_ < REP_DN; ++rep_)
#ifdef PROBE_SPLIT_DN
            _Pragma("unroll 1") for (int half_ = 0; half_ < 2; ++half_) { OPAQUE_IDS EpiPlain E{Hb, DM};
                { pg8::Gemm g_{ACT, wptr(ws, l, kind == 0 ? OFF_DN1 : OFF_DN2), T_TOK, DM, DFF}; pg8::StaticOrder S_; S_.init(T_TOK, DM, G, (int)blockIdx.x); S_.i0 = 2 * half_; S_.iend = 2 * half_ + 2;
                  int l_o_ = lane_id(); asm volatile("" : "+v"(l_o_)); pg8::gemm_phase<EpiPlain, pg8::StaticOrder, true, true>(lds, g_, S_, E, wave * 64 + l_o_); __syncthreads(); }
                if (half_ == 0) xcd_barrier(xbar); }
#else
            if (RUN) { OPAQUE_IDS EpiPlain E{Hb, DM}; GEMM_CALL(EpiPlain, E, ACT, wptr(ws, l, kind == 0 ? OFF_DN1 : OFF_DN2), T_TOK, DM, DFF); }
#endif
#endif
            SEAM;
            if (RUN) { OPAQUE_IDS
                const float* gpost = a.in[kind == 0 ? 4 : 21] + l * DM;
                if (sb == 5) row_pass(nullptr, XN, Hb, 0.5f, gpost, X, nullptr, RSv, gw, NGW, lane);
                else row_pass(nullptr, XN, Hb, 0.5f, gpost, nullptr, XN, RSv, gw, NGW, lane);
            }
            SEAM;
        } else {
            #ifndef NO_WIN
            _Pragma("unroll 1") for (int rep_ = 0; rep_ < REP_WIN; ++rep_)
            if (RUN) { OPAQUE_IDS EpiWin E{ZC, CQ, Ub, Vb, CKV, KR, PQ, PV, PKV, rope, RSv}; GEMM_CALL(EpiWin, E, XN, wptr(ws, l, OFF_IN), T_TOK, NIN_P, DM); }
#endif
            SEAM;
            _Pragma("unroll 1") for (int rep_ = 0; rep_ < REP_MIX2; ++rep_)
            if (RUN) { OPAQUE_IDS
#ifndef NO_UQ
                { EpiUq E{Qb, PQ, rope}; GEMM_CALL(EpiUq, E, CQ, wptr(ws, l, OFF_UQ), T_TOK, NQ, 256); }
#endif
#ifndef NO_UKV
                { EpiUkv E{KVb, PKV}; GEMM_CALL(EpiUkv, E, CKV, wptr(ws, l, OFF_UKV), T_TOK, NKV, 128); }
#endif
#ifndef NO_CONV
                _Pragma("unroll 1") for (int rc_ = 0; rc_ < REP_CONV; ++rc_) { OPAQUE_IDS conv_phase(ZC, a.in[7] + l * 768, a.in[8] + l * 256, Yb, gtid, gthreads); }
#endif
#ifndef NO_GMLP
                _Pragma("unroll 1") for (int rg_ = 0; rg_ < REP_GMLP; ++rg_) { OPAQUE_IDS gmlp_phase(lds, Ub, Vb, PV, a.in[13] + l * 256, wptr(ws, l, OFF_GWS), a.in[15] + l * 512, Yb, gw, NGW, wave, lane); }
#endif
            }
            SEAM;
#ifndef NO_ATTN
            if (RUN) { OPAQUE_IDS attn_phase(lds, Qb, KVb, KR, Yb, vcu, G, tid); }
#ifdef PROBE_DUP_ATTN
            if (RUN) { __syncthreads(); OPAQUE_IDS attn_phase(lds, Qb, KVb, KR, Yb, vcu, G, tid); }
#endif
#endif
            SEAM;
#ifndef NO_OUT
            _Pragma("unroll 1") for (int rep_ = 0; rep_ < REP_WIN; ++rep_)
            if (RUN) { OPAQUE_IDS EpiPlain E{Hb, DM}; GEMM_CALL(EpiPlain, E, Yb, wptr(ws, l, OFF_OUT), T_TOK, DM, DM); }
#endif
            SEAM;
            if (RUN) { OPAQUE_IDS row_pass(nullptr, XN, Hb, 1.0f, a.in[17] + l * DM, nullptr, XN, RSv, gw, NGW, lane); }
            SEAM;
        }
    }
}
constexpr int N_PHASES = 1 + 2 * (3 + 5 + 3);

#ifndef MK_SPLIT
#define MK_SPLIT 0
#endif
extern "C" void kernel_launch(void* const* d_in, const int* in_sizes, int n_in, void* d_out, int out_size, void* d_ws, size_t ws_size, hipStream_t stream) {
    static int grid = 0;
    if (grid == 0) {
        if (n_in != 22 || out_size != T_TOK * DM || ws_size < WS_END) { fprintf(stderr, "kernel_launch: unexpected shapes n_in %d out %d ws %zu\n", n_in, out_size, ws_size); grid = -1; return; }
        int dev = 0, cus = 0, per_cu = 0;
        (void)hipGetDevice(&dev); (void)hipDeviceGetAttribute(&cus, hipDeviceAttributeMultiprocessorCount, dev);
        if (hipFuncSetAttribute((const void*)mk_fwd, hipFuncAttributeMaxDynamicSharedMemorySize, LDS_BYTES) != hipSuccess) { fprintf(stderr, "kernel_launch: hipFuncSetAttribute failed\n"); grid = -1; return; }
        if (hipOccupancyMaxActiveBlocksPerMultiprocessor(&per_cu, (const void*)mk_fwd, NTHR, LDS_BYTES) != hipSuccess || per_cu < 1) { fprintf(stderr, "kernel_launch: occupancy query says %d\n", per_cu); per_cu = 1; }
        (void)hipGetLastError();
        grid = cus * per_cu;
        if (grid > cus) grid = cus;
    }
    if (grid < 0) return;
    Args a{};
    for (int i = 0; i < 22; ++i) a.in[i] = (const float*)d_in[i];
    a.out = (float*)d_out; a.ws = (unsigned char*)d_ws;
#if MK_SPLIT
    for (int p = 0; p < N_PHASES; ++p) { a.ph_lo = p; a.ph_hi = p + 1; hipLaunchKernelGGL(mk_fwd, dim3(grid), dim3(NTHR), LDS_BYTES, stream, a); }
#else
    a.ph_lo = 0; a.ph_hi = N_PHASES;
    void* args[] = {&a};
    hipError_t e = hipLaunchCooperativeKernel((const void*)mk_fwd, dim3(grid), dim3(NTHR), args, LDS_BYTES, stream);
    if (e != hipSuccess) fprintf(stderr, "cooperative launch failed: %s (grid %d)\n", hipGetErrorString(e), grid);
#endif
}
```
